# Optimizing an MI355X kernel written in HIP

```python
import math
import jax, jax.numpy as jnp
from jax import lax
import numpy as np


D_MODEL = 1024
BATCH = 16
SEQ = 4096
DEPTH = 4
DEC_BATCH = 16
DEC_SEQ = 32
PAST_LEN = 4096

CHUNK = 64
D_ATT = D_MODEL // 2
D_SSM = D_MODEL // 2
D_MIX = D_ATT + D_SSM
N_HEADS = D_ATT // 64
HEAD_DIM = 64
SSM_GROUP = 16
N_SSM_GROUPS = D_SSM // SSM_GROUP
STATE_DIM = 64
Q_BLOCK = 128
EPS = 1e-6
D_IN = 4 * D_ATT + 2 * D_SSM

kernel_name = 'hymba_s5_stickbreaking_stream_step'


def _rmsnorm(x, g):
    xf = x.astype(jnp.float32)
    y = xf * lax.rsqrt(jnp.mean(xf * xf, axis=-1, keepdims=True) + EPS) * g.astype(jnp.float32)
    return y.astype(x.dtype)


def _sb_block(q, k, v, q_pos, k_pos):
    z = jnp.einsum('bqhd,bkhd->bhqk', q, k).astype(jnp.float32) * (1.0 / math.sqrt(HEAD_DIM))
    mask = k_pos[None, :] < q_pos[:, None]
    log_rem = jnp.where(mask, jax.nn.log_sigmoid(-z), 0.0)
    after = lax.cumsum(log_rem, axis=3, reverse=True) - log_rem
    w = jnp.where(mask, jnp.exp(jax.nn.log_sigmoid(z) + after), 0.0)
    return jnp.einsum('bhqk,bkhd->bqhd', w.astype(v.dtype), v)


def _sb_prompt(q, k, v):
    B, T, H, Dh = q.shape
    nb = T // Q_BLOCK
    qb = q.reshape(B, nb, Q_BLOCK, H, Dh).transpose(1, 0, 2, 3, 4)
    k_pos = jnp.arange(T)

    def one(args):
        q_blk, i = args
        q_pos = i * Q_BLOCK + jnp.arange(Q_BLOCK)
        return _sb_block(q_blk, k, v, q_pos, k_pos)

    out = lax.map(one, (qb, jnp.arange(nb)))
    return out.transpose(1, 0, 2, 3, 4).reshape(B, T, H * Dh)


def _sb_sample(q, k, v, k_past, v_past):
    B, T, H, Dh = q.shape
    P = k_past.shape[1]
    k_all = jnp.concatenate([k_past.astype(k.dtype), k], axis=1)
    v_all = jnp.concatenate([v_past.astype(v.dtype), v], axis=1)
    q_pos = P + jnp.arange(T)
    k_pos = jnp.arange(P + T)
    return _sb_block(q, k_all, v_all, q_pos, k_pos).reshape(B, T, H * Dh)


def _cmul_combine(e1, e2):
    ar1, ai1, br1, bi1 = e1
    ar2, ai2, br2, bi2 = e2
    ar = ar2 * ar1 - ai2 * ai1
    ai = ar2 * ai1 + ai2 * ar1
    br = ar2 * br1 - ai2 * bi1 + br2
    bi = ar2 * bi1 + ai2 * br1 + bi2
    return (ar, ai, br, bi)


def _ssm_branch(u, h0_re, h0_im, a_re, a_im, log_dt, b_re, b_im, c_re, c_im, d_skip, w_glu, b_glu):
    B, T, _ = u.shape
    f32 = jnp.float32
    a_re = a_re.astype(f32)
    a_im = a_im.astype(f32)
    dt = jnp.exp(log_dt.astype(f32))[:, None]
    mag = jnp.exp(a_re * dt)
    ang = a_im * dt
    ab_re = mag * jnp.cos(ang)
    ab_im = mag * jnp.sin(ang)
    den = a_re * a_re + a_im * a_im
    f_re = ((ab_re - 1.0) * a_re + ab_im * a_im) / den
    f_im = (ab_im * a_re - (ab_re - 1.0) * a_im) / den
    b_re = b_re.astype(f32)
    b_im = b_im.astype(f32)
    bb_re = f_re[..., None] * b_re - f_im[..., None] * b_im
    bb_im = f_re[..., None] * b_im + f_im[..., None] * b_re
    uf = u.astype(f32)
    ug = uf.reshape(B, T, N_SSM_GROUPS, SSM_GROUP)
    bu_re = jnp.einsum('btgc,gpc->tbgp', ug, bb_re)
    bu_im = jnp.einsum('btgc,gpc->tbgp', ug, bb_im)
    if h0_re is not None:
        h0r = h0_re.astype(f32)
        h0i = h0_im.astype(f32)
        bu_re = bu_re.at[0].add(ab_re * h0r - ab_im * h0i)
        bu_im = bu_im.at[0].add(ab_re * h0i + ab_im * h0r)
    a_s_re = jnp.broadcast_to(ab_re, (T, 1, N_SSM_GROUPS, STATE_DIM))
    a_s_im = jnp.broadcast_to(ab_im, (T, 1, N_SSM_GROUPS, STATE_DIM))
    _, _, h_re, h_im = lax.associative_scan(_cmul_combine, (a_s_re, a_s_im, bu_re, bu_im), axis=0)
    y = (jnp.einsum('tbgp,gcp->btgc', h_re, c_re.astype(f32))
         - jnp.einsum('tbgp,gcp->btgc', h_im, c_im.astype(f32)))
    y = y.reshape(B, T, D_SSM) + d_skip.astype(f32) * uf
    y = jax.nn.gelu(y)
    y = y * jax.nn.sigmoid(y @ w_glu.astype(f32) + b_glu.astype(f32))
    return y.astype(u.dtype), h_re[-1], h_im[-1]


def _layer(x, k_past, v_past, h0_re, h0_im, ln_g, w_in, a_re, a_im, log_dt, b_re, b_im,
           c_re, c_im, d_skip, w_glu, b_glu, g_att, g_ssm, w_out):
    B, T, _ = x.shape
    hn = _rmsnorm(x, ln_g)
    proj = hn @ w_in
    q, k, v, ga, u, gs = jnp.split(
        proj, [D_ATT, 2 * D_ATT, 3 * D_ATT, 4 * D_ATT, 4 * D_ATT + D_SSM], axis=-1)
    q = q.reshape(B, T, N_HEADS, HEAD_DIM)
    k = k.reshape(B, T, N_HEADS, HEAD_DIM)
    v = v.reshape(B, T, N_HEADS, HEAD_DIM)
    if k_past is None:
        att = _sb_prompt(q, k, v)
    else:
        att = _sb_sample(q, k, v, k_past, v_past)
    ssm_y, h_re, h_im = _ssm_branch(u, h0_re, h0_im, a_re, a_im, log_dt, b_re, b_im,
                                     c_re, c_im, d_skip, w_glu, b_glu)
    att_o = _rmsnorm(att, g_att) * jax.nn.silu(ga)
    ssm_o = _rmsnorm(ssm_y, g_ssm) * jax.nn.silu(gs)
    out = jnp.concatenate([att_o, ssm_o], axis=-1) @ w_out
    return x + out, k, v, h_re, h_im


def setup_inputs(seed: int = 0) -> dict:
    key = jax.random.key(seed)
    ks = jax.random.split(key, 24)
    f32 = jnp.float32
    G, P, C = N_SSM_GROUPS, STATE_DIM, SSM_GROUP
    x_prompt = jax.random.normal(ks[0], (BATCH, SEQ, D_MODEL), f32)
    x_sample = jax.random.normal(ks[1], (DEC_BATCH, DEC_SEQ, D_MODEL), f32)
    cache_k = jax.random.normal(ks[2], (DEPTH, DEC_BATCH, PAST_LEN, N_HEADS, HEAD_DIM), f32)
    cache_v = jax.random.normal(ks[3], (DEPTH, DEC_BATCH, PAST_LEN, N_HEADS, HEAD_DIM), f32)
    state_ssm_re = 0.5 * jax.random.normal(ks[4], (DEPTH, DEC_BATCH, G, P), f32)
    state_ssm_im = 0.5 * jax.random.normal(ks[5], (DEPTH, DEC_BATCH, G, P), f32)
    ln_g = 1.0 + 0.02 * jax.random.normal(ks[6], (DEPTH, D_MODEL), f32)
    w_in = jax.random.normal(ks[7], (DEPTH, D_MODEL, D_IN), f32) * D_MODEL ** -0.5
    n = jnp.arange(P, dtype=f32)
    ssm_a_re = -0.5 + 0.01 * jax.random.normal(ks[8], (DEPTH, G, P), f32)
    ssm_a_im = math.pi * n + 0.01 * jax.random.normal(ks[9], (DEPTH, G, P), f32)
    ssm_log_dt = jax.random.uniform(ks[10], (DEPTH, G), f32, math.log(1e-3), math.log(1e-1))
    ssm_b_re = jax.random.normal(ks[11], (DEPTH, G, P, C), f32) * (2.0 * C) ** -0.5
    ssm_b_im = jax.random.normal(ks[12], (DEPTH, G, P, C), f32) * (2.0 * C) ** -0.5
    ssm_c_re = jax.random.normal(ks[13], (DEPTH, G, C, P), f32) * (2.0 * P) ** -0.5
    ssm_c_im = jax.random.normal(ks[14], (DEPTH, G, C, P), f32) * (2.0 * P) ** -0.5
    ssm_d = jax.random.normal(ks[15], (DEPTH, D_SSM), f32)
    w_glu = jax.random.normal(ks[16], (DEPTH, D_SSM, D_SSM), f32) * D_SSM ** -0.5
    b_glu = 0.02 * jax.random.normal(ks[17], (DEPTH, D_SSM), f32)
    g_att = 1.0 + 0.02 * jax.random.normal(ks[18], (DEPTH, D_ATT), f32)
    g_ssm = 1.0 + 0.02 * jax.random.normal(ks[19], (DEPTH, D_SSM), f32)
    w_out = jax.random.normal(ks[20], (DEPTH, D_MIX, D_MODEL), f32) * (0.5 * D_MIX ** -0.5)
    final_g = 1.0 + 0.02 * jax.random.normal(ks[21], (D_MODEL,), f32)
    return {'x_prompt': x_prompt, 'x_sample': x_sample,
            'cache_k': cache_k, 'cache_v': cache_v,
            'state_ssm_re': state_ssm_re, 'state_ssm_im': state_ssm_im,
            'ln_g': ln_g, 'w_in': w_in,
            'ssm_a_re': ssm_a_re, 'ssm_a_im': ssm_a_im, 'ssm_log_dt': ssm_log_dt,
            'ssm_b_re': ssm_b_re, 'ssm_b_im': ssm_b_im,
            'ssm_c_re': ssm_c_re, 'ssm_c_im': ssm_c_im, 'ssm_d': ssm_d,
            'w_glu': w_glu, 'b_glu': b_glu, 'g_att': g_att, 'g_ssm': g_ssm,
            'w_out': w_out, 'final_g': final_g}


def reference(x_prompt, x_sample, cache_k, cache_v, state_ssm_re, state_ssm_im,
              ln_g, w_in, ssm_a_re, ssm_a_im, ssm_log_dt, ssm_b_re, ssm_b_im,
              ssm_c_re, ssm_c_im, ssm_d, w_glu, b_glu, g_att, g_ssm, w_out, final_g):
    xp = x_prompt
    xs = x_sample
    kp, vp, hrp, hip = [], [], [], []
    ksl, vsl, hrs, his = [], [], [], []
    for l in range(DEPTH):
        w = (ln_g[l], w_in[l], ssm_a_re[l], ssm_a_im[l], ssm_log_dt[l], ssm_b_re[l], ssm_b_im[l],
             ssm_c_re[l], ssm_c_im[l], ssm_d[l], w_glu[l], b_glu[l], g_att[l], g_ssm[l], w_out[l])
        xp, k1, v1, r1, i1 = _layer(xp, None, None, None, None, *w)
        xs, k2, v2, r2, i2 = _layer(xs, cache_k[l], cache_v[l], state_ssm_re[l], state_ssm_im[l], *w)
        kp.append(k1); vp.append(v1); hrp.append(r1); hip.append(i1)
        ksl.append(k2); vsl.append(v2); hrs.append(r2); his.append(i2)
    y_prompt = _rmsnorm(xp, final_g)
    y_sample = _rmsnorm(xs, final_g)
    return (y_prompt, y_sample,
            jnp.stack(kp), jnp.stack(vp), jnp.stack(hrp), jnp.stack(hip),
            jnp.stack(ksl), jnp.stack(vsl), jnp.stack(hrs), jnp.stack(his))
```

```cpp
#include <hip/hip_runtime.h>
#include <hip/hip_bf16.h>
#include <cstdio>
#include <cstdint>
#include <cmath>
namespace pg8 {
#define PG8_LAS __attribute__((address_space(3)))
typedef unsigned short bf16_t;
typedef short bf16x8 __attribute__((ext_vector_type(8)));
typedef float f32x4 __attribute__((ext_vector_type(4)));
typedef unsigned u32x4 __attribute__((ext_vector_type(4)));
constexpr int BM = 256, BK = 64, HALF = 128, HTB = HALF * BK * 2  , STAGE_BYTES = 8 * HTB, NXCD = 8, WGM = 8;

__host__ __device__ __forceinline__ int lds_byte(int r, int c) { const int st = (r >> 4) * 2 + (c >> 5), rr = r & 15, cc = c & 31, ob = rr * 64 + cc * 2; return st * 1024 + (ob ^ (((ob >> 9) & 1) << 5)); }
__host__ __device__ __forceinline__ void stage_rc(int b, int& R, int& C) { const int st = b / 1024, sb = b % 1024, swz = sb ^ (((sb >> 9) & 1) << 5); R = (st >> 1) * 16 + swz / 64; C = (st & 1) * 32 + (swz % 64) / 2; }
__host__ __device__ __forceinline__ int perm32(int rho) { const int n = rho >> 4, i = rho & 15; return 8 * (i >> 2) + 4 * n + (i & 3); }

struct Unit { int pm, pn; };
struct Gemm { const bf16_t* A; const bf16_t* Bt; int M, N, K; };

struct StaticOrder {
    int nM, nN, nwg, G, c;
    __host__ __device__ void init(int M, int N, int G_, int c_) { nM = M / BM; nN = N / BM; nwg = nM * nN; G = G_; c = c_; }
    __host__ __device__ bool next(int i, Unit& u) const {
        const long L = (long)i * G + c; if (L >= nwg) return false;
        int wgid = (int)L; { const int q = nwg / NXCD, r = nwg % NXCD, xcd = wgid % NXCD, off = wgid / NXCD; wgid = (xcd < r ? xcd * (q + 1) : r * (q + 1) + (xcd - r) * q) + off; }
        const int nig = WGM * nN, gid = wgid / nig, fm = gid * WGM, gsz = (nM - fm) < WGM ? (nM - fm) : WGM;
        u.pm = fm + ((wgid % nig) % gsz); u.pn = (wgid % nig) / gsz; return true;
    }
    __device__ __forceinline__ void a_ready(const Unit&) const {}
    __device__ __forceinline__ void done(const Unit&) const {}
};

__device__ __forceinline__ unsigned cvt_pk_bf16(float lo, float hi) { unsigned r; asm volatile("v_cvt_pk_bf16_f32 %0, %1, %2" : "=v"(r) : "v"(lo), "v"(hi)); return r; }
typedef float f32x2 __attribute__((ext_vector_type(2)));
template <class Epi, class Sched, bool ALIGN_EPI = false, bool SP2 = false>
__device__ __forceinline__ void gemm_phase(PG8_LAS unsigned char* lds, const Gemm g, const Sched& S, const Epi& E) {
    int tid_ = threadIdx.x; asm volatile("" : "+v"(tid_));
    const int tid = tid_, wid = __builtin_amdgcn_readfirstlane(tid >> 6), lane = tid & 63, wr = wid >> 2, wc = wid & 3, fr = lane & 15, fq = lane >> 4;
    const int K = g.K, nt = K / BK;
    unsigned voffA[2], voffB[2];
#pragma unroll
    for (int i = 0; i < 2; ++i) { int R, C; stage_rc(tid * 16 + i * 8192, R, C); const int Rb = Epi::PERM ? ((R & ~31) + perm32(R & 31)) : R;
        voffA[i] = (unsigned)(R * K + C) * 2u; voffB[i] = (unsigned)(Rb * K + C) * 2u; }
    const size_t kstep = (size_t)(BK * 2);
    const size_t hstep = (size_t)HALF * K * 2;
    const size_t tstep = 2 * hstep;
    const unsigned ldsw = (unsigned)wid * 1024u;
    const int aoff = lds_byte(wr * 64 + fr, fq * 8), boff = lds_byte(wc * 32 + fr, fq * 8);
#define PG8_SA(b, h) (((b) * 2 + (h)) * HTB)
#define PG8_SB(b, h) ((4 + (b) * 2 + (h)) * HTB)
#define PG8_STAGE(bufoff, gbase, voff) do { _Pragma("unroll") for (int _i = 0; _i < 2; ++_i) \
        __builtin_amdgcn_global_load_lds((const unsigned*)((const char*)(gbase) + (voff)[_i]), (PG8_LAS unsigned*)(lds + (bufoff) + ldsw + _i * 8192), 16, 0, 0); } while (0)
#define PG8_LDA(dst, b, h) do { _Pragma("unroll") for (int m = 0; m < 4; ++m) _Pragma("unroll") for (int k = 0; k < 2; ++k) dst[m][k] = *(const PG8_LAS bf16x8*)(lds + PG8_SA(b, h) + aoff + m * 2048 + k * 1024); } while (0)
#define PG8_LDB(dst, b, h) do { _Pragma("unroll") for (int n = 0; n < 2; ++n) _Pragma("unroll") for (int k = 0; k < 2; ++k) dst[n][k] = *(const PG8_LAS bf16x8*)(lds + PG8_SB(b, h) + boff + n * 2048 + k * 1024); } while (0)
#define PG8_MMA(ai, bj, At, Bt) do { __builtin_amdgcn_s_setprio(1); _Pragma("unroll") for (int m = 0; m < 4; ++m) _Pragma("unroll") for (int n = 0; n < 2; ++n) _Pragma("unroll") for (int k = 0; k < 2; ++k) \
        acc[ai][bj][m][n] = __builtin_amdgcn_mfma_f32_16x16x32_bf16(Bt[n][k], At[m][k], acc[ai][bj][m][n], 0, 0, 0); __builtin_amdgcn_s_setprio(0); } while (0)
#define PG8_WAIT_V(n) asm volatile("s_waitcnt vmcnt(" #n ")" ::: "memory")
#define PG8_WAIT_L(n) asm volatile("s_waitcnt lgkmcnt(" #n ")" ::: "memory")
#define PG8_BAR __builtin_amdgcn_s_barrier()
#define PG8_SCHED __builtin_amdgcn_sched_barrier(0)
    Unit cur, nxt; int ui = 0;
    if (!S.next(0, cur)) return;
    f32x4 acc[2][2][4][2];
#pragma unroll
    for (int a = 0; a < 2; ++a)
#pragma unroll
        for (int b = 0; b < 2; ++b)
#pragma unroll
            for (int m = 0; m < 4; ++m)
#pragma unroll
                for (int n = 0; n < 2; ++n) acc[a][b][m][n] = (f32x4){0.f, 0.f, 0.f, 0.f};
    bf16x8 At[4][2], B0[2][2], B1[2][2];
    const char* cA = (const char*)g.A + (size_t)cur.pm * tstep; const char* cB = (const char*)g.Bt + (size_t)cur.pn * tstep;
    S.a_ready(cur);
    if constexpr (SP2) {
        PG8_STAGE(PG8_SB(0, 0), cB, voffB); PG8_STAGE(PG8_SB(0, 1), cB + hstep, voffB); PG8_STAGE(PG8_SA(0, 0), cA, voffA); PG8_STAGE(PG8_SA(0, 1), cA + hstep, voffA);
        if (wr == 1) PG8_BAR;
        PG8_WAIT_V(2); PG8_BAR;
        PG8_STAGE(PG8_SB(1, 0), cB + kstep, voffB); PG8_STAGE(PG8_SA(1, 0), cA + kstep, voffA); PG8_STAGE(PG8_SB(1, 1), cB + hstep + kstep, voffB);
        PG8_WAIT_V(6); PG8_BAR;
    } else {
        PG8_STAGE(PG8_SB(0, 0), cB, voffB); PG8_STAGE(PG8_SA(0, 0), cA, voffA); PG8_STAGE(PG8_SB(0, 1), cB + hstep, voffB); PG8_STAGE(PG8_SA(0, 1), cA + hstep, voffA);
        if (wr == 1) PG8_BAR;
        PG8_WAIT_V(4); PG8_BAR;
        PG8_STAGE(PG8_SB(1, 0), cB + kstep, voffB); PG8_STAGE(PG8_SA(1, 0), cA + kstep, voffA); PG8_STAGE(PG8_SB(1, 1), cB + hstep + kstep, voffB);
        PG8_WAIT_V(6); PG8_BAR;
    }
    for (;;) {
        const bool has_next = S.next(ui + 1, nxt);
        const char* nA = has_next ? (const char*)g.A + (size_t)nxt.pm * tstep : cA; const char* nB = has_next ? (const char*)g.Bt + (size_t)nxt.pn * tstep : cB;
        for (int t = 0; t < nt; t += 2) {
            const bool last = (t == nt - 2);
            const char* a1 = cA + (size_t)(t + 1) * kstep;
            const char* a2 = last ? nA : cA + (size_t)(t + 2) * kstep; const char* b2 = last ? nB : cB + (size_t)(t + 2) * kstep;
            const char* a3 = a2 + kstep; const char* b3 = b2 + kstep;
            if (last && has_next) S.a_ready(nxt);
            if constexpr (SP2) {
            PG8_LDB(B0, 0, 0); PG8_LDB(B1, 0, 1); PG8_SCHED; PG8_LDA(At, 0, 0); PG8_STAGE(PG8_SA(1, 1), a1 + hstep, voffA);
            PG8_WAIT_V(8); PG8_WAIT_L(0); PG8_BAR; PG8_MMA(0, 0, At, B0); PG8_MMA(0, 1, At, B1); PG8_BAR; PG8_SCHED;
            PG8_LDA(At, 0, 1); PG8_STAGE(PG8_SB(0, 0), b2, voffB); PG8_STAGE(PG8_SB(0, 1), b2 + hstep, voffB); PG8_STAGE(PG8_SA(0, 0), a2, voffA);
            PG8_WAIT_V(8); PG8_WAIT_L(0); PG8_BAR; PG8_MMA(1, 0, At, B0); PG8_MMA(1, 1, At, B1); PG8_BAR; PG8_SCHED;
            PG8_LDB(B0, 1, 0); PG8_LDB(B1, 1, 1); PG8_SCHED; PG8_LDA(At, 1, 0); PG8_STAGE(PG8_SA(0, 1), a2 + hstep, voffA);
            PG8_WAIT_V(8); PG8_WAIT_L(0); PG8_BAR; PG8_MMA(0, 0, At, B0); PG8_MMA(0, 1, At, B1); PG8_BAR; PG8_SCHED;
            PG8_LDA(At, 1, 1); PG8_STAGE(PG8_SB(1, 0), b3, voffB); PG8_STAGE(PG8_SB(1, 1), b3 + hstep, voffB); PG8_STAGE(PG8_SA(1, 0), a3, voffA);
            PG8_WAIT_V(8); PG8_WAIT_L(0); PG8_BAR; PG8_MMA(1, 0, At, B0); PG8_MMA(1, 1, At, B1); PG8_BAR; PG8_SCHED;
            } else {
            PG8_LDB(B0, 0, 0); PG8_SCHED; PG8_LDA(At, 0, 0); PG8_STAGE(PG8_SA(1, 1), a1 + hstep, voffA);
            PG8_WAIT_L(8); PG8_BAR; PG8_WAIT_L(0); PG8_MMA(0, 0, At, B0); PG8_BAR; PG8_SCHED;
            PG8_LDB(B1, 0, 1); PG8_STAGE(PG8_SB(0, 0), b2, voffB);
            PG8_BAR; PG8_WAIT_L(0); PG8_MMA(0, 1, At, B1); PG8_BAR;
            PG8_LDA(At, 0, 1); PG8_STAGE(PG8_SA(0, 0), a2, voffA);
            PG8_BAR; PG8_WAIT_L(0); PG8_MMA(1, 0, At, B0); PG8_BAR; PG8_SCHED;
            PG8_STAGE(PG8_SB(0, 1), b2 + hstep, voffB);
            PG8_WAIT_V(6); PG8_BAR; PG8_MMA(1, 1, At, B1); PG8_BAR;
            PG8_LDB(B0, 1, 0); PG8_SCHED; PG8_LDA(At, 1, 0); PG8_STAGE(PG8_SA(0, 1), a2 + hstep, voffA);
            PG8_WAIT_L(8); PG8_BAR; PG8_WAIT_L(0); PG8_MMA(0, 0, At, B0); PG8_BAR; PG8_SCHED;
            PG8_LDB(B1, 1, 1); PG8_STAGE(PG8_SB(1, 0), b3, voffB);
            PG8_BAR; PG8_WAIT_L(0); PG8_MMA(0, 1, At, B1); PG8_BAR;
            PG8_LDA(At, 1, 1); PG8_STAGE(PG8_SA(1, 0), a3, voffA);
            PG8_BAR; PG8_WAIT_L(0); PG8_MMA(1, 0, At, B0); PG8_BAR; PG8_SCHED;
            PG8_STAGE(PG8_SB(1, 1), b3 + hstep, voffB);
            PG8_WAIT_V(6); PG8_BAR; PG8_MMA(1, 1, At, B1); PG8_BAR;
            }
        }
        if constexpr (ALIGN_EPI) { if (wr == 0) PG8_BAR; }
        if constexpr (!Epi::AFTER_DRAIN) { E(acc, cur, wr, wc, fr, fq); S.done(cur); }
        if (!has_next) break;
#pragma unroll
        for (int a = 0; a < 2; ++a)
#pragma unroll
            for (int b = 0; b < 2; ++b)
#pragma unroll
                for (int m = 0; m < 4; ++m)
#pragma unroll
                    for (int n = 0; n < 2; ++n) acc[a][b][m][n] = (f32x4){0.f, 0.f, 0.f, 0.f};
        cur = nxt; cA = nA; cB = nB; ++ui;
        if constexpr (ALIGN_EPI) { if (wr == 1) PG8_BAR; }
    }
    PG8_WAIT_V(0);
    if constexpr (!ALIGN_EPI) { if (wr == 0) PG8_BAR; }
    PG8_BAR;
    if constexpr (Epi::AFTER_DRAIN) { E.fused(acc, cur, wr, wc, fr, fq, lds, wid, lane); S.done(cur); }
#undef PG8_SA
#undef PG8_SB
#undef PG8_STAGE
#undef PG8_LDA
#undef PG8_LDB
#undef PG8_MMA
#undef PG8_WAIT_V
#undef PG8_WAIT_L
#undef PG8_BAR
#undef PG8_SCHED
}
}
#define GAS __attribute__((address_space(1)))
#define LAS __attribute__((address_space(3)))
typedef unsigned short bf16;
typedef unsigned v4u __attribute__((ext_vector_type(4)));
typedef float f32x4 __attribute__((ext_vector_type(4)));
typedef short bf16x8 __attribute__((ext_vector_type(8)));
typedef GAS unsigned gu32;
typedef GAS unsigned long long gu64;
#define RLX_AGENT __ATOMIC_RELAXED, __HIP_MEMORY_SCOPE_AGENT
#define LDS_WAIT() asm volatile("s_waitcnt lgkmcnt(0)" ::: "memory")
#define VM_WAIT() asm volatile("s_waitcnt vmcnt(0)" ::: "memory")
__device__ __forceinline__ unsigned long long rt() { return __builtin_amdgcn_s_memrealtime(); }
__device__ __forceinline__ unsigned f2bf(float f) { unsigned u = __builtin_bit_cast(unsigned, f); return (u + 0x7fffu + ((u >> 16) & 1u)) >> 16; }
__device__ __forceinline__ unsigned pk2(float lo, float hi) { return f2bf(lo) | (f2bf(hi) << 16); }

#define XB_TMO      128
#define XB_XCNT(j)  (256  + 64 * (j))
#define XB_XSUB(j)  (1280 + 64 * (j))
#define XB_XGEN(j)  (2304 + 64 * (j))
#define XB_TOP      3328
#define XB_TOPGEN   3392
#define XCD_BAR_WORDS 3456
#define XB_SPIN_CAP (1u << 18)

__device__ __forceinline__ unsigned xb_ld(unsigned* p)              { return __hip_atomic_load(p, __ATOMIC_RELAXED, __HIP_MEMORY_SCOPE_AGENT); }
__device__ __forceinline__ unsigned xb_add(unsigned* p, unsigned v) { return __hip_atomic_fetch_add(p, v, __ATOMIC_RELAXED, __HIP_MEMORY_SCOPE_AGENT); }
__device__ __forceinline__ unsigned xb_xcc_id() { return (unsigned)__builtin_amdgcn_s_getreg((3 << 11) | 20) & 0xFu; }
#define XB_SPIN(cond, bar) do { unsigned _sp = 0; while (cond) { __builtin_amdgcn_s_sleep(1); \
    if ((++_sp & 255u) == 0u) { if (xb_ld(&(bar)[XB_TMO])) break; if (_sp > XB_SPIN_CAP) { atomicAdd(&(bar)[XB_TMO], 1u); break; } } } } while (0)

struct XcdBarrier {
    unsigned* bar; unsigned x;
    volatile LAS unsigned* st;
};

__device__ __forceinline__ XcdBarrier xcd_barrier_post(unsigned* bar, volatile LAS unsigned* st) {
    XcdBarrier b; b.bar = bar; b.x = xb_xcc_id(); b.st = st;
    if (threadIdx.x == 0) (void)xb_add(&bar[XB_XCNT(b.x)], 1u);
    return b;
}
__device__ __forceinline__ void xcd_barrier_complete(unsigned* bar, unsigned x, unsigned& nloc, unsigned& nx) {
    const unsigned G = gridDim.x * gridDim.y * gridDim.z;
    unsigned sum, cnt, mine, sp = 0u;
    for (;;) {
        sum = 0u; cnt = 0u; mine = 0u;
#pragma unroll
        for (unsigned j = 0; j < 16; ++j) { const unsigned c = xb_ld(&bar[XB_XCNT(j)]); sum += c; cnt += (c > 0u) ? 1u : 0u; mine = (j == x) ? c : mine; }
        if (sum == G) break;
        __builtin_amdgcn_s_sleep(1);
        if ((++sp & 255u) == 0u) { if (xb_ld(&bar[XB_TMO])) break; if (sp > XB_SPIN_CAP) { atomicAdd(&bar[XB_TMO], 1u); break; } }
    }
    nloc = mine > 0u ? mine : 1u; nx = cnt > 0u ? cnt : 1u;
}

__device__ __forceinline__ void xcd_barrier(const XcdBarrier& b) {
    asm volatile("s_waitcnt vmcnt(0)" ::: "memory");
    __syncthreads();
    if (threadIdx.x == 0) {
        unsigned* bar = b.bar;
        __builtin_amdgcn_s_waitcnt(0);
        unsigned nloc = b.st[0], nx = b.st[1];
        if (nloc == 0u) { xcd_barrier_complete(bar, b.x, nloc, nx); b.st[0] = nloc; b.st[1] = nx; }
        const unsigned old = xb_add(&bar[XB_XSUB(b.x)], 1u);
        const unsigned gen = old / nloc;
        if (old + 1u == (gen + 1u) * nloc) {
            __builtin_amdgcn_fence(__ATOMIC_RELEASE, "agent");
            asm volatile("s_waitcnt vmcnt(0)" ::: "memory");
            const unsigned og = xb_add(&bar[XB_TOP], 1u);
            const unsigned tg = og / nx;
            if (og + 1u == (tg + 1u) * nx) xb_add(&bar[XB_TOPGEN], 1u);
            else XB_SPIN(xb_ld(&bar[XB_TOPGEN]) == tg, bar);
            __builtin_amdgcn_fence(__ATOMIC_ACQUIRE, "agent");
            xb_add(&bar[XB_XGEN(b.x)], 1u);
            asm volatile("s_waitcnt vmcnt(0)" ::: "memory");
        } else {
            XB_SPIN(xb_ld(&bar[XB_XGEN(b.x)]) == gen, bar);
            __builtin_amdgcn_fence(__ATOMIC_ACQUIRE, "agent");
            asm volatile("s_waitcnt vmcnt(0)" ::: "memory");
        }
    }
    __syncthreads();
}
constexpr int NWAVES = 8;
constexpr int DM = 1024, DHALF = 512, DIN = 3072;
constexpr int NL = 4, NB = 16, TP = 4096, TSM = 32, PAST = 4096, NH = 8, HD = 64, NG = 32, NP = 64, NC = 16;
constexpr int MP = NB * TP, MS = NB * TSM, MT = MP + MS;
constexpr float EPS = 1e-6f;
constexpr float LOG2E = 1.4426950408889634f;
constexpr float QSCALE = 0.125f * LOG2E;
constexpr float EXIT_THR = 7.5e-37f;

constexpr size_t O_YP = 0, O_YS = O_YP + (size_t)MP * DM, O_KP = O_YS + (size_t)MS * DM, O_VP = O_KP + (size_t)NL * MP * DHALF, O_RP = O_VP + (size_t)NL * MP * DHALF,
                 O_IP = O_RP + (size_t)NL * NB * NG * NP, O_KS = O_IP + (size_t)NL * NB * NG * NP, O_VS = O_KS + (size_t)NL * MS * DHALF, O_RS = O_VS + (size_t)NL * MS * DHALF,
                 O_IS = O_RS + (size_t)NL * NB * NG * NP, O_END = O_IS + (size_t)NL * NB * NG * NP;

constexpr size_t MiB = 1u << 20;
constexpr size_t WS_CTL = 0;
constexpr size_t WS_SS = 1 * MiB, CTL_ZERO_BYTES = 3 * MiB;
constexpr size_t WS_PAR = 3 * MiB;
constexpr size_t WS_ABAR = WS_PAR, WS_BBF = WS_PAR + 64 * 1024, WS_CBF = WS_BBF + 512 * 1024;
constexpr size_t WS_WIN = 5 * MiB;
constexpr size_t WS_WOUT = 29 * MiB;
constexpr size_t WS_WGLU = 37 * MiB;
constexpr size_t WS_X = 40 * MiB;
constexpr size_t WS_XB = WS_X + 258 * MiB;
constexpr size_t WS_Q = WS_XB + 129 * MiB;
constexpr size_t WS_KT = WS_Q + 65 * MiB;
constexpr size_t WS_VT = WS_KT + 64 * MiB;
constexpr size_t WS_GA = WS_VT + 64 * MiB;
constexpr size_t WS_U = WS_GA + 65 * MiB;
constexpr size_t WS_GS = WS_U + 65 * MiB;
constexpr size_t WS_ATT = WS_GS + 65 * MiB;
constexpr size_t WS_YPRE = WS_ATT + 65 * MiB;
constexpr size_t WS_SSMY = WS_YPRE + 65 * MiB;
constexpr size_t WS_CAT = WS_SSMY + 65 * MiB;
constexpr size_t WS_END = WS_CAT + 129 * MiB;
constexpr int CW_BAR = 4096;

constexpr int RING_BYTES = 131072;
constexpr int ENDS_OFF = 65536;
constexpr int LDSCTL_OFF = RING_BYTES, MISC_OFF = LDSCTL_OFF + 320;
constexpr int LDS_BYTES = 147456;

typedef float f32x2 __attribute__((ext_vector_type(2)));
typedef float f32x16 __attribute__((ext_vector_type(16)));
typedef __bf16 bf16x2_t __attribute__((ext_vector_type(2)));
typedef short s16x4 __attribute__((ext_vector_type(4)));
__device__ __forceinline__ unsigned cvtpk(float lo, float hi) { f32x2 v = {lo, hi}; bf16x2_t b = __builtin_convertvector(v, bf16x2_t); return __builtin_bit_cast(unsigned, b); }
__device__ __forceinline__ bf16x8 pack8(f32x4 a, f32x4 b) { v4u w; w.x = cvtpk(a[0], a[1]); w.y = cvtpk(a[2], a[3]); w.z = cvtpk(b[0], b[1]); w.w = cvtpk(b[2], b[3]); return __builtin_bit_cast(bf16x8, w); }
__device__ __forceinline__ float bf2f(unsigned short b) { return __builtin_bit_cast(float, (unsigned)b << 16); }
__device__ __forceinline__ float ex2(float x) { return __builtin_amdgcn_exp2f(x); }
__device__ __forceinline__ float rcp(float x) { return __builtin_amdgcn_rcpf(x); }
__device__ __forceinline__ float silu_f(float v) { return v * rcp(1.f + ex2(-LOG2E * v)); }
__device__ __forceinline__ float sigm_f(float v) { return rcp(1.f + ex2(-LOG2E * v)); }
__device__ __forceinline__ float gelu_tanh_f(float y) {
    const float a2 = y * (1.5957691216f + 0.0713548163f * y * y);
    return y * rcp(1.f + ex2(-LOG2E * a2));
}
__device__ __forceinline__ float wave_sum(float v) {
#pragma unroll
    for (int o = 1; o < 64; o <<= 1) v += __shfl_xor(v, o);
    return v;
}
typedef short v4i16_t __attribute__((ext_vector_type(4)));
__device__ __forceinline__ s16x4 vtr(const LAS unsigned char* p) { return __builtin_bit_cast(s16x4, __builtin_amdgcn_ds_read_tr16_b64_v4i16((LAS v4i16_t*)p)); }
#define MFMA32(a, b, c) __builtin_amdgcn_mfma_f32_32x32x16_bf16((a), (b), (c), 0, 0, 0)
#define MFMA16(a, b, c) __builtin_amdgcn_mfma_f32_16x16x32_bf16((a), (b), (c), 0, 0, 0)

struct EpiProj {
    static constexpr bool PERM = true, AFTER_DRAIN = false;
    unsigned char* ws_; float* out_; int l;
    __device__ __forceinline__ void operator()(const pg8::f32x4 (&acc)[2][2][4][2], const pg8::Unit& u, int wr, int wc, int fr, int fq) const {
        GAS unsigned char* wg_ = (GAS unsigned char*)ws_; GAS float* og_ = (GAS float*)out_; asm volatile("" : "+s"(wg_), "+s"(og_)); unsigned char* const w = (unsigned char*)wg_; float* const o = (float*)og_;
        const float* ss = (const float*)(w + WS_SS) + (size_t)l * MT;
        bf16* Q = (bf16*)(w + WS_Q); unsigned char* KT = w + WS_KT; unsigned char* VT = w + WS_VT; bf16* GA = (bf16*)(w + WS_GA); bf16* U = (bf16*)(w + WS_U); bf16* GS = (bf16*)(w + WS_GS);
        float* kp = o + O_KP + (size_t)l * MP * DHALF; float* vp = o + O_VP + (size_t)l * MP * DHALF; float* ks = o + O_KS + (size_t)l * MS * DHALF; float* vs = o + O_VS + (size_t)l * MS * DHALF;
        const int typ = u.pn >> 1;
        const int csb = (u.pn & 1) * 256 + wc * 32 + 8 * fq;
        const int rowb = u.pm * 256 + wr * 64 + fr;
        float rs[2][4];
#pragma unroll
        for (int ai = 0; ai < 2; ++ai)
#pragma unroll
            for (int m = 0; m < 4; ++m) rs[ai][m] = ss[rowb + ai * 128 + m * 16];
#pragma unroll
        for (int ai = 0; ai < 2; ++ai)
#pragma unroll
            for (int m = 0; m < 4; ++m) rs[ai][m] = 1.0f / sqrtf(rs[ai][m] * (1.0f / DM) + EPS);
        if (typ == 0) {
#pragma unroll
            for (int ai = 0; ai < 2; ++ai)
#pragma unroll
                for (int m = 0; m < 4; ++m) { const int row = rowb + ai * 128 + m * 16; const float s = rs[ai][m] * QSCALE;
#pragma unroll
                    for (int bj = 0; bj < 2; ++bj) { const int cs = csb + bj * 128;
                        *(v4u*)(Q + (size_t)row * DHALF + cs) = __builtin_bit_cast(v4u, pack8(acc[ai][bj][m][0] * s, acc[ai][bj][m][1] * s)); } }
        } else if (typ == 1 || typ == 2) {
            const bool isk = (typ == 1); const bool prompt = (u.pm < MP / 256);
            float* of = prompt ? (isk ? kp : vp) : (isk ? ks : vs);
            unsigned char* tb = isk ? KT : VT;
#pragma unroll
            for (int ai = 0; ai < 2; ++ai)
#pragma unroll
                for (int m = 0; m < 4; ++m) { const int row = rowb + ai * 128 + m * 16; const float s = rs[ai][m];
                    const int orow = prompt ? row : row - MP;
#pragma unroll
                    for (int bj = 0; bj < 2; ++bj) { const int cs = csb + bj * 128;
                        const f32x4 v0 = acc[ai][bj][m][0] * s, v1 = acc[ai][bj][m][1] * s;
                        float* op = of + (size_t)orow * DHALF + cs; *(f32x4*)op = v0; *(f32x4*)(op + 4) = v1;
                        if (prompt) { const int b = row >> 12, t = row & 4095, hd = cs >> 6, ch = (cs & 63) >> 3;
                            const size_t tile = ((size_t)(b * NH + hd) * 64 + (t >> 6)) * 8192;
                            const size_t off = isk ? tile + ch * 1024 + (t & 63) * 16 : tile + (ch >> 2) * 4096 + (t & 63) * 64 + (ch & 3) * 16;
                            *(v4u*)(tb + off) = __builtin_bit_cast(v4u, pack8(v0, v1)); } } }
        } else {
            bf16* ob = (typ == 3) ? GA : (typ == 4) ? U : GS; const bool act = (typ != 4);
#pragma unroll
            for (int ai = 0; ai < 2; ++ai)
#pragma unroll
                for (int m = 0; m < 4; ++m) { const int row = rowb + ai * 128 + m * 16; const float s = rs[ai][m];
#pragma unroll
                    for (int bj = 0; bj < 2; ++bj) { const int cs = csb + bj * 128;
                        f32x4 v0 = acc[ai][bj][m][0] * s, v1 = acc[ai][bj][m][1] * s;
                        if (act) {
#pragma unroll
                            for (int e = 0; e < 4; ++e) { v0[e] = silu_f(v0[e]); v1[e] = silu_f(v1[e]); } }
                        *(v4u*)(ob + (size_t)row * DHALF + cs) = __builtin_bit_cast(v4u, pack8(v0, v1)); } }
        }
    }
};
struct EpiGlu {
    static constexpr bool PERM = true, AFTER_DRAIN = false;
    unsigned char* ws_; const float* bias;
    __device__ __forceinline__ void operator()(const pg8::f32x4 (&acc)[2][2][4][2], const pg8::Unit& u, int wr, int wc, int fr, int fq) const {
        GAS unsigned char* wg_ = (GAS unsigned char*)ws_; asm volatile("" : "+s"(wg_)); unsigned char* const w = (unsigned char*)wg_;
        const bf16* Y = (const bf16*)(w + WS_YPRE); bf16* O = (bf16*)(w + WS_SSMY);
        const int cb = u.pn * 256 + wc * 32 + 8 * fq, rowb = u.pm * 256 + wr * 64 + fr;
        f32x4 bv[2][2];
#pragma unroll
        for (int bj = 0; bj < 2; ++bj) { bv[bj][0] = *(const f32x4*)(bias + cb + bj * 128); bv[bj][1] = *(const f32x4*)(bias + cb + bj * 128 + 4); }
#pragma unroll
        for (int ai = 0; ai < 2; ++ai)
#pragma unroll
            for (int m = 0; m < 4; ++m) { const int row = rowb + ai * 128 + m * 16;
#pragma unroll
                for (int bj = 0; bj < 2; ++bj) { const int c = cb + bj * 128;
                    const v4u yw = *(const v4u*)(Y + (size_t)row * DHALF + c);
                    f32x4 v0 = acc[ai][bj][m][0] + bv[bj][0], v1 = acc[ai][bj][m][1] + bv[bj][1];
#pragma unroll
                    for (int e = 0; e < 4; ++e) { const unsigned w0 = yw[e >> 1], w1 = yw[2 + (e >> 1)];
                        const float y0 = (e & 1) ? __builtin_bit_cast(float, w0 & 0xffff0000u) : __builtin_bit_cast(float, w0 << 16);
                        const float y1 = (e & 1) ? __builtin_bit_cast(float, w1 & 0xffff0000u) : __builtin_bit_cast(float, w1 << 16);
                        v0[e] = y0 * sigm_f(v0[e]); v1[e] = y1 * sigm_f(v1[e]); }
                    *(v4u*)(O + (size_t)row * DHALF + c) = __builtin_bit_cast(v4u, pack8(v0, v1)); } }
    }
};
struct EpiOut {
    static constexpr bool PERM = true, AFTER_DRAIN = false;
    unsigned char* ws_; const float* xp0; const float* xs0; int l;
    __device__ __forceinline__ void operator()(const pg8::f32x4 (&acc)[2][2][4][2], const pg8::Unit& u, int wr, int wc, int fr, int fq) const {
        GAS unsigned char* wg_ = (GAS unsigned char*)ws_; asm volatile("" : "+s"(wg_)); unsigned char* const w = (unsigned char*)wg_;
        float* X = (float*)(w + WS_X); bf16* XB = (bf16*)(w + WS_XB); float* ssn = (float*)(w + WS_SS) + (size_t)(l + 1) * MT;
        const float* xin_p = (l == 0) ? xp0 : X; const float* xin_s = (l == 0) ? xs0 : X + (size_t)MP * DM;
        const int cb = u.pn * 256 + wc * 32 + 8 * fq, rowb = u.pm * 256 + wr * 64 + fr;
        const bool prompt = (u.pm < MP / 256);
#pragma unroll
        for (int ai = 0; ai < 2; ++ai)
#pragma unroll
            for (int m = 0; m < 4; ++m) { const int row = rowb + ai * 128 + m * 16;
                const float* xr = prompt ? xin_p + (size_t)row * DM : xin_s + (size_t)(row - MP) * DM;
                float sq = 0.f;
#pragma unroll
                for (int bj = 0; bj < 2; ++bj) { const int c = cb + bj * 128;
                    const f32x4 v0 = acc[ai][bj][m][0] + *(const f32x4*)(xr + c), v1 = acc[ai][bj][m][1] + *(const f32x4*)(xr + c + 4);
                    float* xo = X + (size_t)row * DM + c; *(f32x4*)xo = v0; *(f32x4*)(xo + 4) = v1;
                    *(v4u*)(XB + (size_t)row * DM + c) = __builtin_bit_cast(v4u, pack8(v0, v1));
                    sq += (v0[0] * v0[0] + v0[1] * v0[1]) + (v0[2] * v0[2] + v0[3] * v0[3]) + (v1[0] * v1[0] + v1[1] * v1[1]) + (v1[2] * v1[2] + v1[3] * v1[3]); }
                sq += __shfl_xor(sq, 16); sq += __shfl_xor(sq, 32);
                if (fq == 0) unsafeAtomicAdd(ssn + row, sq); }
    }
};

template <bool SAMPLE>
__device__ __forceinline__ void attn_tile(LAS unsigned char* vl, const int lane, const int t0, const int jmax,
                                          const bf16* __restrict__ Qp, const unsigned char* __restrict__ Kt, const unsigned char* __restrict__ Vt,
                                          const float* __restrict__ Kc, const float* __restrict__ Vc, const float* __restrict__ Kn, const float* __restrict__ Vn,
                                          bf16* __restrict__ Op) {
    const int q = lane & 31, h = lane >> 5;
    const int qpos = t0 + q;
    bf16x8 qf[4];
#pragma unroll
    for (int ds = 0; ds < 4; ++ds) qf[ds] = *(const bf16x8*)(Qp + (size_t)q * DHALF + ds * 16 + h * 8);
    const int kslot = 16 * ((q >> 2) & 1) + (q & 3) + 4 * (q >> 3);
    const int mg = (lane >> 4) & 1, qq = (lane >> 2) & 3, pp = lane & 3;
    const int trb = (16 * h + qq) * 64 + (16 * (pp & 1) + 8 * mg + 4 * (pp >> 1)) * 2;
    f32x16 o0, o1;
#pragma unroll
    for (int r = 0; r < 16; ++r) { o0[r] = 0.f; o1[r] = 0.f; }
    float C = 1.f;
    bf16x8 kf[2][4]; v4u vr[8];
#define LOAD_K(j_) do { const int jj_ = (j_); \
        if constexpr (!SAMPLE) { \
            const unsigned char* kb_ = Kt + (size_t)jj_ * 8192 + h * 1024 + kslot * 16; \
            _Pragma("unroll") for (int kh = 0; kh < 2; ++kh) \
                _Pragma("unroll") for (int ds = 0; ds < 4; ++ds) kf[kh][ds] = *(const bf16x8*)(kb_ + ds * 2048 + kh * 512); \
        } else { \
            _Pragma("unroll") for (int kh = 0; kh < 2; ++kh) { int pos_ = 64 * jj_ + 32 * kh + kslot; pos_ = pos_ > PAST + TSM - 1 ? PAST + TSM - 1 : pos_; \
                const float* src_ = (pos_ < PAST) ? Kc + (size_t)pos_ * DHALF : Kn + (size_t)(pos_ - PAST) * DHALF; \
                _Pragma("unroll") for (int ds = 0; ds < 4; ++ds) { const f32x4 a_ = *(const f32x4*)(src_ + ds * 16 + h * 8), b_ = *(const f32x4*)(src_ + ds * 16 + h * 8 + 4); kf[kh][ds] = pack8(a_, b_); } } \
        } } while (0)
#define LOAD_V(j_) do { const int jj_ = (j_); \
        if constexpr (!SAMPLE) { \
            const unsigned char* vb_ = Vt + (size_t)jj_ * 8192 + lane * 16; \
            _Pragma("unroll") for (int it = 0; it < 8; ++it) vr[it] = *(const v4u*)(vb_ + it * 1024); \
        } else { \
            _Pragma("unroll") for (int it = 0; it < 8; ++it) { int pos_ = 64 * jj_ + it * 8 + (lane >> 3); pos_ = pos_ > PAST + TSM - 1 ? PAST + TSM - 1 : pos_; \
                const float* src_ = ((pos_ < PAST) ? Vc + (size_t)pos_ * DHALF : Vn + (size_t)(pos_ - PAST) * DHALF) + (lane & 7) * 8; \
                const f32x4 a_ = *(const f32x4*)src_, b_ = *(const f32x4*)(src_ + 4); vr[it] = __builtin_bit_cast(v4u, pack8(a_, b_)); } \
        } } while (0)
    LOAD_K(jmax); LOAD_V(jmax);
    for (int j = jmax;; --j) {
        f32x16 p0, p1;
#pragma unroll
        for (int r = 0; r < 16; ++r) { p0[r] = 0.f; p1[r] = 0.f; }
#pragma unroll
        for (int ds = 0; ds < 4; ++ds) { p0 = MFMA32(kf[0][ds], qf[ds], p0); p1 = MFMA32(kf[1][ds], qf[ds], p1); }
        if constexpr (!SAMPLE) {
#pragma unroll
            for (int it = 0; it < 8; ++it) *(LAS v4u*)(vl + it * 1024 + lane * 16) = vr[it];
        } else {
#pragma unroll
            for (int it = 0; it < 8; ++it) { const int key = it * 8 + (lane >> 3), ch = lane & 7; *(LAS v4u*)(vl + (ch >> 2) * 4096 + key * 64 + (ch & 3) * 16) = vr[it]; }
        }
        if constexpr (!SAMPLE) { if (j > 0) { LOAD_K(j - 1); LOAD_V(j - 1); } }
        const int kb0 = 64 * j + 16 * h;
        if (64 * j + 63 >= t0) {
#pragma unroll
            for (int r = 0; r < 16; ++r) { if (kb0 + r >= qpos) p0[r] = -INFINITY; if (kb0 + 32 + r >= qpos) p1[r] = -INFINITY; }
        }
#pragma unroll
        for (int r = 0; r < 16; ++r) { p0[r] = rcp(1.f + ex2(p0[r])); p1[r] = rcp(1.f + ex2(p1[r])); }
        float T0 = p0[0] * p0[1], T1 = p1[0] * p1[1];
#pragma unroll
        for (int r = 2; r < 16; ++r) { T0 *= p0[r]; T1 *= p1[r]; }
        const float T0p = __shfl_xor(T0, 32), T1p = __shfl_xor(T1, 32);
        const float base1 = h ? C : C * T1p;
        const float base0 = h ? C * (T1 * T1p) : C * (T1 * T1p) * T0p;
        C = C * (T1 * T1p) * (T0 * T0p);
        { float E = base1;
#pragma unroll
          for (int r = 15; r >= 0; --r) { const float rr = p1[r]; p1[r] = __builtin_fmaf(-rr, E, E); E *= rr; } }
        { float E = base0;
#pragma unroll
          for (int r = 15; r >= 0; --r) { const float rr = p0[r]; p0[r] = __builtin_fmaf(-rr, E, E); E *= rr; } }
        bf16x8 w[2][2];
        { v4u t;
          t.x = cvtpk(p0[0], p0[1]); t.y = cvtpk(p0[2], p0[3]); t.z = cvtpk(p0[4], p0[5]); t.w = cvtpk(p0[6], p0[7]); w[0][0] = __builtin_bit_cast(bf16x8, t);
          t.x = cvtpk(p0[8], p0[9]); t.y = cvtpk(p0[10], p0[11]); t.z = cvtpk(p0[12], p0[13]); t.w = cvtpk(p0[14], p0[15]); w[0][1] = __builtin_bit_cast(bf16x8, t);
          t.x = cvtpk(p1[0], p1[1]); t.y = cvtpk(p1[2], p1[3]); t.z = cvtpk(p1[4], p1[5]); t.w = cvtpk(p1[6], p1[7]); w[1][0] = __builtin_bit_cast(bf16x8, t);
          t.x = cvtpk(p1[8], p1[9]); t.y = cvtpk(p1[10], p1[11]); t.z = cvtpk(p1[12], p1[13]); t.w = cvtpk(p1[14], p1[15]); w[1][1] = __builtin_bit_cast(bf16x8, t); }
        asm volatile("" ::: "memory");
#pragma unroll
        for (int kh = 0; kh < 2; ++kh)
#pragma unroll
            for (int s = 0; s < 2; ++s) {
                const LAS unsigned char* vp = vl + trb + (32 * kh + 8 * s) * 64;
                const s16x4 a0l = vtr(vp), a0h = vtr(vp + 256), a1l = vtr(vp + 4096), a1h = vtr(vp + 4096 + 256);
                const bf16x8 A0 = {a0l[0], a0l[1], a0l[2], a0l[3], a0h[0], a0h[1], a0h[2], a0h[3]};
                const bf16x8 A1 = {a1l[0], a1l[1], a1l[2], a1l[3], a1h[0], a1h[1], a1h[2], a1h[3]};
                o0 = MFMA32(A0, w[kh][s], o0); o1 = MFMA32(A1, w[kh][s], o1);
            }
        asm volatile("" ::: "memory");
        if (j == 0) break;
        if (__all(C < EXIT_THR)) break;
        if constexpr (SAMPLE) { LOAD_K(j - 1); LOAD_V(j - 1); }
    }
    bf16* op = Op + (size_t)q * DHALF + 16 * h;
    { f32x4 a = {o0[0], o0[1], o0[2], o0[3]}, b = {o0[4], o0[5], o0[6], o0[7]}, c = {o0[8], o0[9], o0[10], o0[11]}, d = {o0[12], o0[13], o0[14], o0[15]};
      *(v4u*)op = __builtin_bit_cast(v4u, pack8(a, b)); *(v4u*)(op + 8) = __builtin_bit_cast(v4u, pack8(c, d)); }
    { f32x4 a = {o1[0], o1[1], o1[2], o1[3]}, b = {o1[4], o1[5], o1[6], o1[7]}, c = {o1[8], o1[9], o1[10], o1[11]}, d = {o1[12], o1[13], o1[14], o1[15]};
      *(v4u*)(op + 32) = __builtin_bit_cast(v4u, pack8(a, b)); *(v4u*)(op + 40) = __builtin_bit_cast(v4u, pack8(c, d)); }
}

#undef LOAD_K
#undef LOAD_V

template <bool PASS2>
__device__ __forceinline__ void ssm_pass(LAS unsigned char* vl, const int lane, const int g, const bf16* __restrict__ U, bf16* __restrict__ Y,
                                         const int sbase0, const int sbase1, const int nsteps,
                                         const bf16x8 (&bre)[2], const bf16x8 (&bim)[2], const float (&ar)[2], const float (&ai)[2],
                                         const bf16x8 (&cf)[4], const bf16x8 df, float (&sr)[2], float (&si)[2]) {
    const int m = lane & 31, kh = lane >> 5;
    const int sm = (m >> 2) & 1, tok = (m & 3) + 4 * (m >> 3);
    const bf16* up = U + (size_t)((sm ? sbase1 : sbase0) + tok) * DHALF + g * NC + kh * 8;
    const int tk = lane & 15, kg = lane >> 4, qq = (lane >> 2) & 3, pp = lane & 3;
    for (int step = 0; step < nsteps; ++step) {
        const bf16x8 uf = *(const bf16x8*)(up + (size_t)step * 16 * DHALF);
        f32x16 z;
#pragma unroll
        for (int r = 0; r < 16; ++r) z[r] = 0.f;
        f32x16 br[2], bi[2];
#pragma unroll
        for (int pt = 0; pt < 2; ++pt) { br[pt] = MFMA32(uf, bre[pt], z); bi[pt] = MFMA32(uf, bim[pt], z); }
#pragma unroll
        for (int pt = 0; pt < 2; ++pt)
#pragma unroll
            for (int r = 0; r < 16; ++r) {
                const float nr = __builtin_fmaf(ar[pt], sr[pt], __builtin_fmaf(-ai[pt], si[pt], br[pt][r]));
                const float ni = __builtin_fmaf(ar[pt], si[pt], __builtin_fmaf(ai[pt], sr[pt], bi[pt][r]));
                sr[pt] = nr; si[pt] = ni;
                if constexpr (PASS2) { br[pt][r] = nr; bi[pt][r] = ni; }
            }
        if constexpr (PASS2) {
#pragma unroll
            for (int pt = 0; pt < 2; ++pt) {
                LAS unsigned char* wre = vl + kh * 4096 + (m + 32 * pt) * 32;
                LAS unsigned char* wim = wre + 64 * 32;
                { f32x4 a = {br[pt][0], br[pt][1], br[pt][2], br[pt][3]}, b = {br[pt][4], br[pt][5], br[pt][6], br[pt][7]}, c = {br[pt][8], br[pt][9], br[pt][10], br[pt][11]}, d = {br[pt][12], br[pt][13], br[pt][14], br[pt][15]};
                  *(LAS v4u*)wre = __builtin_bit_cast(v4u, pack8(a, b)); *(LAS v4u*)(wre + 16) = __builtin_bit_cast(v4u, pack8(c, d)); }
                { f32x4 a = {bi[pt][0], bi[pt][1], bi[pt][2], bi[pt][3]}, b = {bi[pt][4], bi[pt][5], bi[pt][6], bi[pt][7]}, c = {bi[pt][8], bi[pt][9], bi[pt][10], bi[pt][11]}, d = {bi[pt][12], bi[pt][13], bi[pt][14], bi[pt][15]};
                  *(LAS v4u*)wim = __builtin_bit_cast(v4u, pack8(a, b)); *(LAS v4u*)(wim + 16) = __builtin_bit_cast(v4u, pack8(c, d)); }
            }
            asm volatile("" ::: "memory");
#pragma unroll
            for (int s = 0; s < 2; ++s) {
                pg8::f32x4 y = {0.f, 0.f, 0.f, 0.f};
                const LAS unsigned char* hp = vl + s * 4096 + (8 * kg + qq) * 32 + pp * 8;
#pragma unroll
                for (int ks = 0; ks < 4; ++ks) {
                    const s16x4 lo = vtr(hp + ks * 32 * 32), hi = vtr(hp + ks * 32 * 32 + 4 * 32);
                    const bf16x8 hf = {lo[0], lo[1], lo[2], lo[3], hi[0], hi[1], hi[2], hi[3]};
                    y = MFMA16(cf[ks], hf, y);
                }
                const size_t trow = (size_t)((s ? sbase1 : sbase0) + step * 16 + tk);
                v4u uw = *(const v4u*)(U + trow * DHALF + g * NC + (kg & 1) * 8);
                if (kg >= 2) uw = (v4u){0u, 0u, 0u, 0u};
                y = MFMA16(df, __builtin_bit_cast(bf16x8, uw), y);
                uint2 o; o.x = cvtpk(gelu_tanh_f(y[0]), gelu_tanh_f(y[1])); o.y = cvtpk(gelu_tanh_f(y[2]), gelu_tanh_f(y[3]));
                *(uint2*)(Y + trow * DHALF + g * NC + 4 * kg) = o;
            }
            asm volatile("" ::: "memory");
        }
    }
}
struct SsmPar { bf16x8 bre[2], bim[2]; float ar[2], ai[2]; };
__device__ __forceinline__ void ssm_load_par(SsmPar& P, const float* ABAR, const bf16* BBF, int l, int g, int lane) {
    const int p = lane & 31, kh = lane >> 5;
#pragma unroll
    for (int pt = 0; pt < 2; ++pt) {
        const f32x2 a = *(const f32x2*)(ABAR + ((size_t)(l * NG + g) * NP + p + 32 * pt) * 2); P.ar[pt] = a.x; P.ai[pt] = a.y;
        P.bre[pt] = *(const bf16x8*)(BBF + (((size_t)(l * NG + g) * 2 + 0) * NP + p + 32 * pt) * NC + kh * 8);
        P.bim[pt] = *(const bf16x8*)(BBF + (((size_t)(l * NG + g) * 2 + 1) * NP + p + 32 * pt) * NC + kh * 8);
    }
}
__device__ __forceinline__ void ssm_load_cd(bf16x8 (&cf)[4], bf16x8& df, const bf16* CBF, const float* dsk, int l, int g, int lane) {
    const int c = lane & 15, kg = lane >> 4;
#pragma unroll
    for (int ks = 0; ks < 4; ++ks) cf[ks] = *(const bf16x8*)(CBF + ((size_t)(l * NG + g) * NC + c) * (2 * NP) + 32 * ks + 8 * kg);
    const float dv = dsk[(size_t)l * DHALF + g * NC + c];
    const unsigned short db = (unsigned short)(cvtpk(dv, 0.f) & 0xffffu);
#pragma unroll
    for (int j = 0; j < 8; ++j) df[j] = (short)((kg < 2 && 8 * kg + j == c) ? db : 0);
}
struct Args { const float* in[22]; float* out; unsigned char* ws; };
enum { I_XP = 0, I_XS, I_CK, I_CV, I_SR, I_SI, I_LNG, I_WIN, I_ARE, I_AIM, I_LDT, I_BRE, I_BIM, I_CRE, I_CIM, I_D, I_WGLU, I_BGLU, I_GATT, I_GSSM, I_WOUT, I_FG };

__device__ __forceinline__ void transpose_item(const float* W, int K, int N, bf16* WT, const float* kscale, LAS float* scr, int item, int lane) {
    const int nblk = N / 32, kb = item / nblk, nb = item % nblk, k0 = 64 * kb, n0 = 32 * nb;
#pragma unroll 8
    for (int i = 0; i < 32; ++i) { const int kk = 2 * i + (lane >> 5); float v = W[(size_t)(k0 + kk) * N + n0 + (lane & 31)]; if (kscale) v *= kscale[k0 + kk]; scr[kk * 33 + (lane & 31)] = v; }
    LDS_WAIT(); asm volatile("" ::: "memory");
    const int c = lane & 7;
#pragma unroll
    for (int j = 0; j < 4; ++j) { const int n = (lane >> 3) + 8 * j; const LAS float* s = scr + (8 * c) * 33 + n;
        v4u o; o.x = cvtpk(s[0 * 33], s[1 * 33]); o.y = cvtpk(s[2 * 33], s[3 * 33]); o.z = cvtpk(s[4 * 33], s[5 * 33]); o.w = cvtpk(s[6 * 33], s[7 * 33]);
        *(v4u*)(WT + (size_t)(n0 + n) * K + k0 + 8 * c) = o; }
    LDS_WAIT(); asm volatile("" ::: "memory");
}

constexpr int TBL_OFF = LDSCTL_OFF + 1024;
__device__ __forceinline__ const float* inptr(LAS unsigned char* lds, int i) {
    const unsigned long long v = *(volatile LAS unsigned long long*)(lds + TBL_OFF + 8 * i);
    const unsigned lo = __builtin_amdgcn_readfirstlane((unsigned)v), hi = __builtin_amdgcn_readfirstlane((unsigned)(v >> 32));
    return (const float*)(GAS const float*)(((unsigned long long)hi << 32) | lo);
}
__global__ void __launch_bounds__(NWAVES * 64, 2) hymba_fwd(Args args) {
    extern __shared__ __attribute__((aligned(16))) unsigned char lds_raw[];
    LAS unsigned char* lds = (LAS unsigned char*)lds_raw;
    volatile LAS unsigned* MISC = (volatile LAS unsigned*)(lds + MISC_OFF);
    const int tid = threadIdx.x, lane0 = tid & 63, wave = __builtin_amdgcn_readfirstlane(tid >> 6);
    const int G = gridDim.x, bid = blockIdx.x;
    unsigned char* const ws = args.ws;
    float* const out = args.out;
    for (int u = tid; u < (LDS_BYTES - LDSCTL_OFF) / 4; u += NWAVES * 64) ((LAS unsigned*)(lds + LDSCTL_OFF))[u] = 0u;
    __syncthreads();
    if (tid < 22) *(LAS unsigned long long*)(lds + TBL_OFF + 8 * tid) = (unsigned long long)args.in[tid];
    __syncthreads();
    XcdBarrier bar = xcd_barrier_post((unsigned*)(ws + WS_CTL) + CW_BAR, MISC + 8);
    const int gw = bid * NWAVES + wave, NGW = G * NWAVES;
    LAS unsigned char* wl = lds + wave * 8192;
#define INP(i) inptr(lds, (i))
#define LNL int lane = lane0; asm volatile("" : "+v"(lane))
#define WSL(name) GAS unsigned char* name##_g = (GAS unsigned char*)ws; asm volatile("" : "+s"(name##_g)); unsigned char* const name = (unsigned char*)name##_g

#ifndef SKIP_P0
    {
        LAS float* scr = (LAS float*)(lds + wave * 16384);
        WSL(w); LNL;
        float* SS = (float*)(w + WS_SS); float* ABAR = (float*)(w + WS_ABAR); bf16* BBF = (bf16*)(w + WS_BBF); bf16* CBF = (bf16*)(w + WS_CBF);
        bf16* WIN = (bf16*)(w + WS_WIN); bf16* WOUT = (bf16*)(w + WS_WOUT); bf16* WGLU = (bf16*)(w + WS_WGLU); bf16* XB = (bf16*)(w + WS_XB);
        constexpr int I_IN = (DM / 64) * (DIN / 32), I_OUT = (DM / 64) * (DM / 32), I_GLU = (DHALF / 64) * (DHALF / 32);
        constexpr int PER_L = I_IN + I_OUT + I_GLU, NITEMS = NL * PER_L;
        for (int it = gw; it < NITEMS; it += NGW) {
            const int l = it / PER_L; int r = it % PER_L;
            if (r < I_IN) { transpose_item(INP(I_WIN) + (size_t)l * DM * DIN, DM, DIN, WIN + (size_t)l * DIN * DM, INP(I_LNG) + (size_t)l * DM, scr, r, lane); continue; } r -= I_IN;
            if (r < I_OUT) { transpose_item(INP(I_WOUT) + (size_t)l * DM * DM, DM, DM, WOUT + (size_t)l * DM * DM, nullptr, scr, r, lane); continue; } r -= I_OUT;
            transpose_item(INP(I_WGLU) + (size_t)l * DHALF * DHALF, DHALF, DHALF, WGLU + (size_t)l * DHALF * DHALF, nullptr, scr, r, lane);
        }
        for (int i = bid * (NWAVES * 64) + tid; i < NL * NG * NP; i += G * NWAVES * 64) {
            const int p = i % NP, lg = i / NP;
            const float dt = expf(INP(I_LDT)[lg]);
            const float are = INP(I_ARE)[i], aim = INP(I_AIM)[i];
            const float mag = expf(are * dt), ang = aim * dt;
            const float abr = mag * cosf(ang), abi = mag * sinf(ang);
            const float den = are * are + aim * aim;
            const float fre = ((abr - 1.0f) * are + abi * aim) / den, fim = (abi * are - (abr - 1.0f) * aim) / den;
            ABAR[(size_t)i * 2] = abr; ABAR[(size_t)i * 2 + 1] = abi;
            const float* bre = INP(I_BRE) + (size_t)i * NC; const float* bim = INP(I_BIM) + (size_t)i * NC;
#pragma unroll
            for (int c = 0; c < NC; c += 2) {
                const float r0 = fre * bre[c] - fim * bim[c], i0 = fre * bim[c] + fim * bre[c];
                const float r1 = fre * bre[c + 1] - fim * bim[c + 1], i1 = fre * bim[c + 1] + fim * bre[c + 1];
                *(unsigned*)(BBF + (((size_t)lg * 2 + 0) * NP + p) * NC + c) = cvtpk(r0, r1);
                *(unsigned*)(BBF + (((size_t)lg * 2 + 1) * NP + p) * NC + c) = cvtpk(i0, i1);
            }
            const float* cre = INP(I_CRE); const float* cim = INP(I_CIM);
#pragma unroll
            for (int c = 0; c < NC; ++c) {
                const float cr = cre[((size_t)lg * NC + c) * NP + p], ci = cim[((size_t)lg * NC + c) * NP + p];
                CBF[((size_t)lg * NC + c) * (2 * NP) + p] = (bf16)(cvtpk(cr, 0.f) & 0xffffu);
                CBF[((size_t)lg * NC + c) * (2 * NP) + NP + p] = (bf16)(cvtpk(-ci, 0.f) & 0xffffu);
            }
        }
        const float* xp = INP(I_XP); const float* xs = INP(I_XS);
        for (int row = gw; row < MT; row += NGW) {
            const float* xr = (row < MP) ? xp + (size_t)row * DM : xs + (size_t)(row - MP) * DM;
            float s = 0.f;
#pragma unroll
            for (int j = 0; j < 2; ++j) { const f32x4 a = *(const f32x4*)(xr + j * 512 + lane * 8), b = *(const f32x4*)(xr + j * 512 + lane * 8 + 4);
                s += (a[0] * a[0] + a[1] * a[1]) + (a[2] * a[2] + a[3] * a[3]) + (b[0] * b[0] + b[1] * b[1]) + (b[2] * b[2] + b[3] * b[3]);
                *(v4u*)(XB + (size_t)row * DM + j * 512 + lane * 8) = __builtin_bit_cast(v4u, pack8(a, b)); }
            s = wave_sum(s);
            if (lane == 0) SS[row] = s;
        }
    }
#endif
    xcd_barrier(bar);

    for (int l = 0; l < NL; ++l) {
#ifndef SKIP_P1
        {
            WSL(w);
            pg8::Gemm g{(const bf16*)(w + WS_XB), (const bf16*)(w + WS_WIN) + (size_t)l * DIN * DM, MT, DIN, DM}; pg8::StaticOrder S; S.init(MT, DIN, G, bid);
            EpiProj E{ws, out, l};
            pg8::gemm_phase<EpiProj, pg8::StaticOrder, true, true>(lds, g, S, E);
        }
#endif
        xcd_barrier(bar);
#ifndef SKIP_P2
        {
#ifndef SKIP_SSM
            for (int ui = bid; ui < NB * NG; ui += G) {
                const int b = ui >> 5, g = ui & 31;
                WSL(w); LNL;
                const float* ABAR = (const float*)(w + WS_ABAR); const bf16* BBF = (const bf16*)(w + WS_BBF); const bf16* CBF = (const bf16*)(w + WS_CBF); const bf16* UB = (const bf16*)(w + WS_U); bf16* YPRE = (bf16*)(w + WS_YPRE);
                SsmPar P; ssm_load_par(P, ABAR, BBF, l, g, lane);
                const int h = lane >> 5, p = lane & 31;
                const int sb0 = b * TP + (2 * wave) * 256, sb1 = sb0 + 256;
                float sr[2] = {0.f, 0.f}, si[2] = {0.f, 0.f};
                bf16x8 cf[4]; bf16x8 df;
#pragma unroll
                for (int ks = 0; ks < 4; ++ks) cf[ks] = (bf16x8){0, 0, 0, 0, 0, 0, 0, 0};
                df = (bf16x8){0, 0, 0, 0, 0, 0, 0, 0};
                ssm_pass<false>(wl, lane, g, UB, YPRE, sb0, sb1, 16, P.bre, P.bim, P.ar, P.ai, cf, df, sr, si);
                LAS f32x2* ends = (LAS f32x2*)(lds + ENDS_OFF);
#pragma unroll
                for (int pt = 0; pt < 2; ++pt) ends[(2 * wave + h) * NP + p + 32 * pt] = (f32x2){sr[pt], si[pt]};
                __syncthreads();
                const int myS = 2 * wave + h;
#pragma unroll
                for (int pt = 0; pt < 2; ++pt) {
                    float a2r = P.ar[pt], a2i = P.ai[pt];
#pragma unroll
                    for (int i = 0; i < 8; ++i) { const float t = a2r * a2r - a2i * a2i; a2i = 2.f * a2r * a2i; a2r = t; }
                    float cr = 0.f, ci = 0.f;
                    for (int s2 = 0; s2 < 15; ++s2) {
                        const f32x2 e = ends[s2 * NP + p + 32 * pt];
                        const float nr = a2r * cr - a2i * ci + e.x, ni = a2r * ci + a2i * cr + e.y;
                        if (s2 < myS) { cr = nr; ci = ni; }
                    }
                    sr[pt] = cr; si[pt] = ci;
                }
                ssm_load_cd(cf, df, CBF, INP(I_D), l, g, lane);
                ssm_pass<true>(wl, lane, g, UB, YPRE, sb0, sb1, 16, P.bre, P.bim, P.ar, P.ai, cf, df, sr, si);
                if (wave == NWAVES - 1 && h == 1) {
#pragma unroll
                    for (int pt = 0; pt < 2; ++pt) { const size_t o = ((size_t)(l * NB + b) * NG + g) * NP + p + 32 * pt; out[O_RP + o] = sr[pt]; out[O_IP + o] = si[pt]; }
                }
                __syncthreads();
            }
#endif
#ifndef SKIP_SSMS
            for (int g = G - 1 - bid; g >= 0 && g < NG; g += G) {
                WSL(w); LNL;
                const float* ABAR = (const float*)(w + WS_ABAR); const bf16* BBF = (const bf16*)(w + WS_BBF); const bf16* CBF = (const bf16*)(w + WS_CBF); const bf16* UB = (const bf16*)(w + WS_U); bf16* YPRE = (bf16*)(w + WS_YPRE);
                const float* isr = INP(I_SR); const float* isi = INP(I_SI);
                SsmPar P; ssm_load_par(P, ABAR, BBF, l, g, lane);
                const int h = lane >> 5, p = lane & 31, b = 2 * wave + h;
                float sr[2], si[2];
#pragma unroll
                for (int pt = 0; pt < 2; ++pt) { const size_t o = ((size_t)(l * NB + b) * NG + g) * NP + p + 32 * pt; sr[pt] = isr[o]; si[pt] = isi[o]; }
                bf16x8 cf[4]; bf16x8 df; ssm_load_cd(cf, df, CBF, INP(I_D), l, g, lane);
                ssm_pass<true>(wl, lane, g, UB, YPRE, MP + (2 * wave) * TSM, MP + (2 * wave + 1) * TSM, 2, P.bre, P.bim, P.ar, P.ai, cf, df, sr, si);
#pragma unroll
                for (int pt = 0; pt < 2; ++pt) { const size_t o = ((size_t)(l * NB + b) * NG + g) * NP + p + 32 * pt; out[O_RS + o] = sr[pt]; out[O_IS + o] = si[pt]; }
            }
#endif
#ifndef SKIP_ATT
            for (int c8 = bid; c8 < MP / 256; c8 += G) {
                WSL(w); LNL;
                const bf16* QB = (const bf16*)(w + WS_Q); const unsigned char* KT = w + WS_KT; const unsigned char* VT = w + WS_VT; bf16* ATT = (bf16*)(w + WS_ATT);
                for (int uu = 0; uu < 8; ++uu) {
                    const int unit = c8 * 8 + uu, b = unit >> 7, t0 = (unit & 127) * 32, row0 = b * TP + t0;
                    const size_t hb = (size_t)(b * NH + wave) * 64 * 8192;
                    attn_tile<false>(wl, lane, t0, (t0 + 30) >> 6, QB + (size_t)row0 * DHALF + wave * HD, KT + hb, VT + hb, nullptr, nullptr, nullptr, nullptr, ATT + (size_t)row0 * DHALF + wave * HD);
                }
            }
#endif
#ifndef SKIP_ATTS
            for (int b = bid; b < NB; b += G) {
                WSL(w); LNL;
                const bf16* QB = (const bf16*)(w + WS_Q); bf16* ATT = (bf16*)(w + WS_ATT);
                const float* ksm = out + O_KS + (size_t)l * MS * DHALF; const float* vsm = out + O_VS + (size_t)l * MS * DHALF;
                const int row0 = MP + b * TSM;
                const size_t cb = ((size_t)(l * NB + b) * PAST) * DHALF + wave * HD;
                attn_tile<true>(wl, lane, PAST, (PAST + 30) >> 6, QB + (size_t)row0 * DHALF + wave * HD, nullptr, nullptr, INP(I_CK) + cb, INP(I_CV) + cb,
                                ksm + (size_t)(b * TSM) * DHALF + wave * HD, vsm + (size_t)(b * TSM) * DHALF + wave * HD, ATT + (size_t)row0 * DHALF + wave * HD);
            }
#endif
        }
#endif
        xcd_barrier(bar);
#ifndef SKIP_P3
        {
            WSL(w);
            pg8::Gemm g{(const bf16*)(w + WS_YPRE), (const bf16*)(w + WS_WGLU) + (size_t)l * DHALF * DHALF, MT, DHALF, DHALF}; pg8::StaticOrder S; S.init(MT, DHALF, G, bid);
            EpiGlu E{ws, INP(I_BGLU) + (size_t)l * DHALF};
            pg8::gemm_phase<EpiGlu, pg8::StaticOrder, true, true>(lds, g, S, E);
        }
#endif
        xcd_barrier(bar);
#ifndef SKIP_P4
        {
            WSL(w); LNL;
            const bf16* ATT = (const bf16*)(w + WS_ATT); const bf16* SSMY = (const bf16*)(w + WS_SSMY); const bf16* GA = (const bf16*)(w + WS_GA); const bf16* GS = (const bf16*)(w + WS_GS); bf16* CAT = (bf16*)(w + WS_CAT);
            const float* gat = INP(I_GATT) + (size_t)l * DHALF; const float* gss = INP(I_GSSM) + (size_t)l * DHALF;
            const f32x4 ga0 = *(const f32x4*)(gat + lane * 8), ga1 = *(const f32x4*)(gat + lane * 8 + 4), gs0 = *(const f32x4*)(gss + lane * 8), gs1 = *(const f32x4*)(gss + lane * 8 + 4);
            for (int row = gw; row < MT; row += NGW) {
                const size_t o = (size_t)row * DHALF + lane * 8;
                const v4u aw = *(const v4u*)(ATT + o), sw = *(const v4u*)(SSMY + o), gaw = *(const v4u*)(GA + o), gsw = *(const v4u*)(GS + o);
                float av[8], sv[8], gav[8], gsv[8]; float qa = 0.f, qs = 0.f;
#pragma unroll
                for (int e = 0; e < 4; ++e) {
                    av[2 * e] = __builtin_bit_cast(float, aw[e] << 16); av[2 * e + 1] = __builtin_bit_cast(float, aw[e] & 0xffff0000u);
                    sv[2 * e] = __builtin_bit_cast(float, sw[e] << 16); sv[2 * e + 1] = __builtin_bit_cast(float, sw[e] & 0xffff0000u);
                    gav[2 * e] = __builtin_bit_cast(float, gaw[e] << 16); gav[2 * e + 1] = __builtin_bit_cast(float, gaw[e] & 0xffff0000u);
                    gsv[2 * e] = __builtin_bit_cast(float, gsw[e] << 16); gsv[2 * e + 1] = __builtin_bit_cast(float, gsw[e] & 0xffff0000u);
                }
#pragma unroll
                for (int e = 0; e < 8; ++e) { qa += av[e] * av[e]; qs += sv[e] * sv[e]; }
                qa = wave_sum(qa); qs = wave_sum(qs);
                const float ra = 1.0f / sqrtf(qa * (1.0f / DHALF) + EPS), rsn = 1.0f / sqrtf(qs * (1.0f / DHALF) + EPS);
                f32x4 o0, o1, o2, o3;
#pragma unroll
                for (int e = 0; e < 4; ++e) { o0[e] = av[e] * ra * ga0[e] * gav[e]; o1[e] = av[4 + e] * ra * ga1[e] * gav[4 + e]; o2[e] = sv[e] * rsn * gs0[e] * gsv[e]; o3[e] = sv[4 + e] * rsn * gs1[e] * gsv[4 + e]; }
                *(v4u*)(CAT + (size_t)row * DM + lane * 8) = __builtin_bit_cast(v4u, pack8(o0, o1));
                *(v4u*)(CAT + (size_t)row * DM + DHALF + lane * 8) = __builtin_bit_cast(v4u, pack8(o2, o3));
            }
        }
#endif
        xcd_barrier(bar);
#ifndef SKIP_P5
        {
            WSL(w);
            pg8::Gemm g{(const bf16*)(w + WS_CAT), (const bf16*)(w + WS_WOUT) + (size_t)l * DM * DM, MT, DM, DM}; pg8::StaticOrder S; S.init(MT, DM, G, bid);
            EpiOut E{ws, INP(I_XP), INP(I_XS), l};
            pg8::gemm_phase<EpiOut, pg8::StaticOrder, true, true>(lds, g, S, E);
        }
#endif
        xcd_barrier(bar);
    }
    {
        WSL(w); LNL;
        const float* X = (const float*)(w + WS_X);
        const float* fg = INP(I_FG); const float* ssf = (const float*)(w + WS_SS) + (size_t)NL * MT;
        f32x4 gv[4];
#pragma unroll
        for (int j = 0; j < 4; ++j) gv[j] = *(const f32x4*)(fg + j * 256 + lane * 4);
        for (int row = gw; row < MT; row += NGW) {
            const float rs = 1.0f / sqrtf(ssf[row] * (1.0f / DM) + EPS);
            const float* xr = X + (size_t)row * DM; float* yo = (row < MP) ? out + O_YP + (size_t)row * DM : out + O_YS + (size_t)(row - MP) * DM;
#pragma unroll
            for (int j = 0; j < 4; ++j) { const f32x4 v = *(const f32x4*)(xr + j * 256 + lane * 4); *(f32x4*)(yo + j * 256 + lane * 4) = v * rs * gv[j]; }
        }
    }
}

extern "C" void kernel_launch(void* const* d_in, const int* in_sizes, int n_in, void* d_out, int out_size, void* d_ws, size_t ws_size, hipStream_t stream) {
    static int grid = 0;
    if (grid == 0) {
        if (n_in != 22 || in_sizes[0] != MP * DM || (size_t)out_size != O_END || ws_size < WS_END) {
            fprintf(stderr, "kernel_launch: unexpected shapes: n_in %d in0 %d out %d ws %zu (need %zu); nothing launched\n", n_in, n_in > 0 ? in_sizes[0] : -1, out_size, ws_size, (size_t)WS_END); grid = -1; return; }
        int dev = 0, cus = 0, per_cu = 0;
        if (hipGetDevice(&dev) != hipSuccess || hipDeviceGetAttribute(&cus, hipDeviceAttributeMultiprocessorCount, dev) != hipSuccess) { grid = -1; return; }
        if (hipFuncSetAttribute((const void*)hymba_fwd, hipFuncAttributeMaxDynamicSharedMemorySize, LDS_BYTES) != hipSuccess) { fprintf(stderr, "kernel_launch: hipFuncSetAttribute failed\n"); grid = -1; return; }
        if (hipOccupancyMaxActiveBlocksPerMultiprocessor(&per_cu, (const void*)hymba_fwd, NWAVES * 64, LDS_BYTES) != hipSuccess || per_cu < 1)
            fprintf(stderr, "kernel_launch: note: occupancy query reports %d workgroups per CU\n", per_cu);
        (void)hipGetLastError();
        grid = cus;
    }
    if (grid < 0) return;
    if (hipMemsetAsync((char*)d_ws + WS_CTL, 0, CTL_ZERO_BYTES, stream) != hipSuccess) { fprintf(stderr, "kernel_launch: memset failed\n"); return; }
    Args a{};
    for (int i = 0; i < 22; ++i) a.in[i] = (const float*)d_in[i];
    a.out = (float*)d_out; a.ws = (unsigned char*)d_ws;
    hipLaunchKernelGGL(hymba_fwd, dim3(grid), dim3(NWAVES * 64), LDS_BYTES, stream, a);
    const hipError_t le = hipPeekAtLastError();
    if (le != hipSuccess) fprintf(stderr, "kernel_launch: launch failed: %s\n", hipGetErrorName(le));
}
```

```cpp
#include <hip/hip_runtime.h>
#include <hip/hip_bf16.h>
#include <cstdio>
#include <cstdint>
#include <cmath>
namespace pg8 {
#define PG8_LAS __attribute__((address_space(3)))
typedef unsigned short bf16_t;
typedef short bf16x8 __attribute__((ext_vector_type(8)));
typedef float f32x4 __attribute__((ext_vector_type(4)));
typedef unsigned u32x4 __attribute__((ext_vector_type(4)));
constexpr int BM = 256, BK = 64, HALF = 128, HTB = HALF * BK * 2  , STAGE_BYTES = 8 * HTB, NXCD = 8, WGM = 8;

__host__ __device__ __forceinline__ int lds_byte(int r, int c) { const int st = (r >> 4) * 2 + (c >> 5), rr = r & 15, cc = c & 31, ob = rr * 64 + cc * 2; return st * 1024 + (ob ^ (((ob >> 9) & 1) << 5)); }
__host__ __device__ __forceinline__ void stage_rc(int b, int& R, int& C) { const int st = b / 1024, sb = b % 1024, swz = sb ^ (((sb >> 9) & 1) << 5); R = (st >> 1) * 16 + swz / 64; C = (st & 1) * 32 + (swz % 64) / 2; }
__host__ __device__ __forceinline__ int perm32(int rho) { const int n = rho >> 4, i = rho & 15; return 8 * (i >> 2) + 4 * n + (i & 3); }

struct Unit { int pm, pn; };
struct Gemm { const bf16_t* A; const bf16_t* Bt; int M, N, K; };

struct StaticOrder {
    int nM, nN, nwg, G, c;
    __host__ __device__ void init(int M, int N, int G_, int c_) { nM = M / BM; nN = N / BM; nwg = nM * nN; G = G_; c = c_; }
    __host__ __device__ bool next(int i, Unit& u) const {
        const long L = (long)i * G + c; if (L >= nwg) return false;
        int wgid = (int)L; { const int q = nwg / NXCD, r = nwg % NXCD, xcd = wgid % NXCD, off = wgid / NXCD; wgid = (xcd < r ? xcd * (q + 1) : r * (q + 1) + (xcd - r) * q) + off; }
        const int nig = WGM * nN, gid = wgid / nig, fm = gid * WGM, gsz = (nM - fm) < WGM ? (nM - fm) : WGM;
        u.pm = fm + ((wgid % nig) % gsz); u.pn = (wgid % nig) / gsz; return true;
    }
    __device__ __forceinline__ void a_ready(const Unit&) const {}
    __device__ __forceinline__ void done(const Unit&) const {}
};

__device__ __forceinline__ unsigned cvt_pk_bf16(float lo, float hi) { unsigned r; asm volatile("v_cvt_pk_bf16_f32 %0, %1, %2" : "=v"(r) : "v"(lo), "v"(hi)); return r; }
typedef float f32x2 __attribute__((ext_vector_type(2)));
template <class Epi, class Sched, bool ALIGN_EPI = false, bool SP2 = false>
__device__ __forceinline__ void gemm_phase(PG8_LAS unsigned char* lds, const Gemm g, const Sched& S, const Epi& E) {
    int tid_ = threadIdx.x; asm volatile("" : "+v"(tid_));
    const int tid = tid_, wid = __builtin_amdgcn_readfirstlane(tid >> 6), lane = tid & 63, wr = wid >> 2, wc = wid & 3, fr = lane & 15, fq = lane >> 4;
    const int K = g.K, nt = K / BK;
    unsigned voffA[2], voffB[2];
#pragma unroll
    for (int i = 0; i < 2; ++i) { int R, C; stage_rc(tid * 16 + i * 8192, R, C); const int Rb = Epi::PERM ? ((R & ~31) + perm32(R & 31)) : R;
        voffA[i] = (unsigned)(R * K + C) * 2u; voffB[i] = (unsigned)(Rb * K + C) * 2u; }
    const size_t kstep = (size_t)(BK * 2);
    const size_t hstep = (size_t)HALF * K * 2;
    const size_t tstep = 2 * hstep;
    const unsigned ldsw = (unsigned)wid * 1024u;
    const int aoff = lds_byte(wr * 64 + fr, fq * 8), boff = lds_byte(wc * 32 + fr, fq * 8);
#define PG8_SA(b, h) (((b) * 2 + (h)) * HTB)
#define PG8_SB(b, h) ((4 + (b) * 2 + (h)) * HTB)
#define PG8_STAGE(bufoff, gbase, voff) do { _Pragma("unroll") for (int _i = 0; _i < 2; ++_i) \
        __builtin_amdgcn_global_load_lds((const unsigned*)((const char*)(gbase) + (voff)[_i]), (PG8_LAS unsigned*)(lds + (bufoff) + ldsw + _i * 8192), 16, 0, 0); } while (0)
#define PG8_LDA(dst, b, h) do { _Pragma("unroll") for (int m = 0; m < 4; ++m) _Pragma("unroll") for (int k = 0; k < 2; ++k) dst[m][k] = *(const PG8_LAS bf16x8*)(lds + PG8_SA(b, h) + aoff + m * 2048 + k * 1024); } while (0)
#define PG8_LDB(dst, b, h) do { _Pragma("unroll") for (int n = 0; n < 2; ++n) _Pragma("unroll") for (int k = 0; k < 2; ++k) dst[n][k] = *(const PG8_LAS bf16x8*)(lds + PG8_SB(b, h) + boff + n * 2048 + k * 1024); } while (0)
#define PG8_MMA(ai, bj, At, Bt) do { __builtin_amdgcn_s_setprio(1); _Pragma("unroll") for (int m = 0; m < 4; ++m) _Pragma("unroll") for (int n = 0; n < 2; ++n) _Pragma("unroll") for (int k = 0; k < 2; ++k) \
        acc[ai][bj][m][n] = __builtin_amdgcn_mfma_f32_16x16x32_bf16(Bt[n][k], At[m][k], acc[ai][bj][m][n], 0, 0, 0); __builtin_amdgcn_s_setprio(0); } while (0)
#define PG8_WAIT_V(n) asm volatile("s_waitcnt vmcnt(" #n ")" ::: "memory")
#define PG8_WAIT_L(n) asm volatile("s_waitcnt lgkmcnt(" #n ")" ::: "memory")
#define PG8_BAR __builtin_amdgcn_s_barrier()
#define PG8_SCHED __builtin_amdgcn_sched_barrier(0)
    Unit cur, nxt; int ui = 0;
    if (!S.next(0, cur)) return;
    f32x4 acc[2][2][4][2];
#pragma unroll
    for (int a = 0; a < 2; ++a)
#pragma unroll
        for (int b = 0; b < 2; ++b)
#pragma unroll
            for (int m = 0; m < 4; ++m)
#pragma unroll
                for (int n = 0; n < 2; ++n) acc[a][b][m][n] = (f32x4){0.f, 0.f, 0.f, 0.f};
    bf16x8 At[4][2], B0[2][2], B1[2][2];
    const char* cA = (const char*)g.A + (size_t)cur.pm * tstep; const char* cB = (const char*)g.Bt + (size_t)cur.pn * tstep;
    S.a_ready(cur);
    if constexpr (SP2) {
        PG8_STAGE(PG8_SB(0, 0), cB, voffB); PG8_STAGE(PG8_SB(0, 1), cB + hstep, voffB); PG8_STAGE(PG8_SA(0, 0), cA, voffA); PG8_STAGE(PG8_SA(0, 1), cA + hstep, voffA);
        if (wr == 1) PG8_BAR;
        PG8_WAIT_V(2); PG8_BAR;
        PG8_STAGE(PG8_SB(1, 0), cB + kstep, voffB); PG8_STAGE(PG8_SA(1, 0), cA + kstep, voffA); PG8_STAGE(PG8_SB(1, 1), cB + hstep + kstep, voffB);
        PG8_WAIT_V(6); PG8_BAR;
    } else {
        PG8_STAGE(PG8_SB(0, 0), cB, voffB); PG8_STAGE(PG8_SA(0, 0), cA, voffA); PG8_STAGE(PG8_SB(0, 1), cB + hstep, voffB); PG8_STAGE(PG8_SA(0, 1), cA + hstep, voffA);
        if (wr == 1) PG8_BAR;
        PG8_WAIT_V(4); PG8_BAR;
        PG8_STAGE(PG8_SB(1, 0), cB + kstep, voffB); PG8_STAGE(PG8_SA(1, 0), cA + kstep, voffA); PG8_STAGE(PG8_SB(1, 1), cB + hstep + kstep, voffB);
        PG8_WAIT_V(6); PG8_BAR;
    }
    for (;;) {
        const bool has_next = S.next(ui + 1, nxt);
        const char* nA = has_next ? (const char*)g.A + (size_t)nxt.pm * tstep : cA; const char* nB = has_next ? (const char*)g.Bt + (size_t)nxt.pn * tstep : cB;
        for (int t = 0; t < nt; t += 2) {
            const bool last = (t == nt - 2);
            const char* a1 = cA + (size_t)(t + 1) * kstep;
            const char* a2 = last ? nA : cA + (size_t)(t + 2) * kstep; const char* b2 = last ? nB : cB + (size_t)(t + 2) * kstep;
            const char* a3 = a2 + kstep; const char* b3 = b2 + kstep;
            if (last && has_next) S.a_ready(nxt);
            if constexpr (SP2) {
            PG8_LDB(B0, 0, 0); PG8_LDB(B1, 0, 1); PG8_SCHED; PG8_LDA(At, 0, 0); PG8_STAGE(PG8_SA(1, 1), a1 + hstep, voffA);
            PG8_WAIT_V(8); PG8_WAIT_L(0); PG8_BAR; PG8_MMA(0, 0, At, B0); PG8_MMA(0, 1, At, B1); PG8_BAR; PG8_SCHED;
            PG8_LDA(At, 0, 1); PG8_STAGE(PG8_SB(0, 0), b2, voffB); PG8_STAGE(PG8_SB(0, 1), b2 + hstep, voffB); PG8_STAGE(PG8_SA(0, 0), a2, voffA);
            PG8_WAIT_V(8); PG8_WAIT_L(0); PG8_BAR; PG8_MMA(1, 0, At, B0); PG8_MMA(1, 1, At, B1); PG8_BAR; PG8_SCHED;
            PG8_LDB(B0, 1, 0); PG8_LDB(B1, 1, 1); PG8_SCHED; PG8_LDA(At, 1, 0); PG8_STAGE(PG8_SA(0, 1), a2 + hstep, voffA);
            PG8_WAIT_V(8); PG8_WAIT_L(0); PG8_BAR; PG8_MMA(0, 0, At, B0); PG8_MMA(0, 1, At, B1); PG8_BAR; PG8_SCHED;
            PG8_LDA(At, 1, 1); PG8_STAGE(PG8_SB(1, 0), b3, voffB); PG8_STAGE(PG8_SB(1, 1), b3 + hstep, voffB); PG8_STAGE(PG8_SA(1, 0), a3, voffA);
            PG8_WAIT_V(8); PG8_WAIT_L(0); PG8_BAR; PG8_MMA(1, 0, At, B0); PG8_MMA(1, 1, At, B1); PG8_BAR; PG8_SCHED;
            } else {
            PG8_LDB(B0, 0, 0); PG8_SCHED; PG8_LDA(At, 0, 0); PG8_STAGE(PG8_SA(1, 1), a1 + hstep, voffA);
            PG8_WAIT_L(8); PG8_BAR; PG8_WAIT_L(0); PG8_MMA(0, 0, At, B0); PG8_BAR; PG8_SCHED;
            PG8_LDB(B1, 0, 1); PG8_STAGE(PG8_SB(0, 0), b2, voffB);
            PG8_BAR; PG8_WAIT_L(0); PG8_MMA(0, 1, At, B1); PG8_BAR;
            PG8_LDA(At, 0, 1); PG8_STAGE(PG8_SA(0, 0), a2, voffA);
            PG8_BAR; PG8_WAIT_L(0); PG8_MMA(1, 0, At, B0); PG8_BAR; PG8_SCHED;
            PG8_STAGE(PG8_SB(0, 1), b2 + hstep, voffB);
            PG8_WAIT_V(6); PG8_BAR; PG8_MMA(1, 1, At, B1); PG8_BAR;
            PG8_LDB(B0, 1, 0); PG8_SCHED; PG8_LDA(At, 1, 0); PG8_STAGE(PG8_SA(0, 1), a2 + hstep, voffA);
            PG8_WAIT_L(8); PG8_BAR; PG8_WAIT_L(0); PG8_MMA(0, 0, At, B0); PG8_BAR; PG8_SCHED;
            PG8_LDB(B1, 1, 1); PG8_STAGE(PG8_SB(1, 0), b3, voffB);
            PG8_BAR; PG8_WAIT_L(0); PG8_MMA(0, 1, At, B1); PG8_BAR;
            PG8_LDA(At, 1, 1); PG8_STAGE(PG8_SA(1, 0), a3, voffA);
            PG8_BAR; PG8_WAIT_L(0); PG8_MMA(1, 0, At, B0); PG8_BAR; PG8_SCHED;
            PG8_STAGE(PG8_SB(1, 1), b3 + hstep, voffB);
            PG8_WAIT_V(6); PG8_BAR; PG8_MMA(1, 1, At, B1); PG8_BAR;
            }
        }
        if constexpr (ALIGN_EPI) { if (wr == 0) PG8_BAR; }
        if constexpr (!Epi::AFTER_DRAIN) { E(acc, cur, wr, wc, fr, fq); S.done(cur); }
        if (!has_next) break;
#pragma unroll
        for (int a = 0; a < 2; ++a)
#pragma unroll
            for (int b = 0; b < 2; ++b)
#pragma unroll
                for (int m = 0; m < 4; ++m)
#pragma unroll
                    for (int n = 0; n < 2; ++n) acc[a][b][m][n] = (f32x4){0.f, 0.f, 0.f, 0.f};
        cur = nxt; cA = nA; cB = nB; ++ui;
        if constexpr (ALIGN_EPI) { if (wr == 1) PG8_BAR; }
    }
    PG8_WAIT_V(0);
    if constexpr (!ALIGN_EPI) { if (wr == 0) PG8_BAR; }
    PG8_BAR;
    if constexpr (Epi::AFTER_DRAIN) { E.fused(acc, cur, wr, wc, fr, fq, lds, wid, lane); S.done(cur); }
#undef PG8_SA
#undef PG8_SB
#undef PG8_STAGE
#undef PG8_LDA
#undef PG8_LDB
#undef PG8_MMA
#undef PG8_WAIT_V
#undef PG8_WAIT_L
#undef PG8_BAR
#undef PG8_SCHED
}
}
#define GAS __attribute__((address_space(1)))
#define LAS __attribute__((address_space(3)))
typedef unsigned short bf16;
typedef unsigned v4u __attribute__((ext_vector_type(4)));
typedef float f32x4 __attribute__((ext_vector_type(4)));
typedef short bf16x8 __attribute__((ext_vector_type(8)));
typedef GAS unsigned gu32;
typedef GAS unsigned long long gu64;
#define RLX_AGENT __ATOMIC_RELAXED, __HIP_MEMORY_SCOPE_AGENT
#define LDS_WAIT() asm volatile("s_waitcnt lgkmcnt(0)" ::: "memory")
#define VM_WAIT() asm volatile("s_waitcnt vmcnt(0)" ::: "memory")
__device__ __forceinline__ unsigned long long rt() { return __builtin_amdgcn_s_memrealtime(); }
__device__ __forceinline__ unsigned f2bf(float f) { unsigned u = __builtin_bit_cast(unsigned, f); return (u + 0x7fffu + ((u >> 16) & 1u)) >> 16; }
__device__ __forceinline__ unsigned pk2(float lo, float hi) { return f2bf(lo) | (f2bf(hi) << 16); }

#define XB_TMO      128
#define XB_XCNT(j)  (256  + 64 * (j))
#define XB_XSUB(j)  (1280 + 64 * (j))
#define XB_XGEN(j)  (2304 + 64 * (j))
#define XB_TOP      3328
#define XB_TOPGEN   3392
#define XCD_BAR_WORDS 3456
#define XB_SPIN_CAP (1u << 18)

__device__ __forceinline__ unsigned xb_ld(unsigned* p)              { return __hip_atomic_load(p, __ATOMIC_RELAXED, __HIP_MEMORY_SCOPE_AGENT); }
__device__ __forceinline__ unsigned xb_add(unsigned* p, unsigned v) { return __hip_atomic_fetch_add(p, v, __ATOMIC_RELAXED, __HIP_MEMORY_SCOPE_AGENT); }
__device__ __forceinline__ unsigned xb_xcc_id() { return (unsigned)__builtin_amdgcn_s_getreg((3 << 11) | 20) & 0xFu; }
#define XB_SPIN(cond, bar) do { unsigned _sp = 0; while (cond) { __builtin_amdgcn_s_sleep(1); \
    if ((++_sp & 255u) == 0u) { if (xb_ld(&(bar)[XB_TMO])) break; if (_sp > XB_SPIN_CAP) { atomicAdd(&(bar)[XB_TMO], 1u); break; } } } } while (0)

struct XcdBarrier {
    unsigned* bar; unsigned x;
    volatile LAS unsigned* st;
};

__device__ __forceinline__ XcdBarrier xcd_barrier_post(unsigned* bar, volatile LAS unsigned* st) {
    XcdBarrier b; b.bar = bar; b.x = xb_xcc_id(); b.st = st;
    if (threadIdx.x == 0) (void)xb_add(&bar[XB_XCNT(b.x)], 1u);
    return b;
}
__device__ __forceinline__ void xcd_barrier_complete(unsigned* bar, unsigned x, unsigned& nloc, unsigned& nx) {
    const unsigned G = gridDim.x * gridDim.y * gridDim.z;
    unsigned sum, cnt, mine, sp = 0u;
    for (;;) {
        sum = 0u; cnt = 0u; mine = 0u;
#pragma unroll
        for (unsigned j = 0; j < 16; ++j) { const unsigned c = xb_ld(&bar[XB_XCNT(j)]); sum += c; cnt += (c > 0u) ? 1u : 0u; mine = (j == x) ? c : mine; }
        if (sum == G) break;
        __builtin_amdgcn_s_sleep(1);
        if ((++sp & 255u) == 0u) { if (xb_ld(&bar[XB_TMO])) break; if (sp > XB_SPIN_CAP) { atomicAdd(&bar[XB_TMO], 1u); break; } }
    }
    nloc = mine > 0u ? mine : 1u; nx = cnt > 0u ? cnt : 1u;
}

__device__ __forceinline__ void xcd_barrier(const XcdBarrier& b) {
    asm volatile("s_waitcnt vmcnt(0)" ::: "memory");
    __syncthreads();
    if (threadIdx.x == 0) {
        unsigned* bar = b.bar;
        __builtin_amdgcn_s_waitcnt(0);
        unsigned nloc = b.st[0], nx = b.st[1];
        if (nloc == 0u) { xcd_barrier_complete(bar, b.x, nloc, nx); b.st[0] = nloc; b.st[1] = nx; }
        const unsigned old = xb_add(&bar[XB_XSUB(b.x)], 1u);
        const unsigned gen = old / nloc;
        if (old + 1u == (gen + 1u) * nloc) {
            __builtin_amdgcn_fence(__ATOMIC_RELEASE, "agent");
            asm volatile("s_waitcnt vmcnt(0)" ::: "memory");
            const unsigned og = xb_add(&bar[XB_TOP], 1u);
            const unsigned tg = og / nx;
            if (og + 1u == (tg + 1u) * nx) xb_add(&bar[XB_TOPGEN], 1u);
            else XB_SPIN(xb_ld(&bar[XB_TOPGEN]) == tg, bar);
            __builtin_amdgcn_fence(__ATOMIC_ACQUIRE, "agent");
            xb_add(&bar[XB_XGEN(b.x)], 1u);
            asm volatile("s_waitcnt vmcnt(0)" ::: "memory");
        } else {
            XB_SPIN(xb_ld(&bar[XB_XGEN(b.x)]) == gen, bar);
            __builtin_amdgcn_fence(__ATOMIC_ACQUIRE, "agent");
            asm volatile("s_waitcnt vmcnt(0)" ::: "memory");
        }
    }
    __syncthreads();
}
constexpr int NWAVES = 8;
constexpr int DM = 1024, DHALF = 512, DIN = 3072;
constexpr int NL = 4, NB = 16, TP = 4096, TSM = 32, PAST = 4096, NH = 8, HD = 64, NG = 32, NP = 64, NC = 16;
constexpr int MP = NB * TP, MS = NB * TSM, MT = MP + MS;
constexpr float EPS = 1e-6f;
constexpr float LOG2E = 1.4426950408889634f;
constexpr float QSCALE = 0.125f * LOG2E;
constexpr float EXIT_THR = 7.5e-37f;

constexpr size_t O_YP = 0, O_YS = O_YP + (size_t)MP * DM, O_KP = O_YS + (size_t)MS * DM, O_VP = O_KP + (size_t)NL * MP * DHALF, O_RP = O_VP + (size_t)NL * MP * DHALF,
                 O_IP = O_RP + (size_t)NL * NB * NG * NP, O_KS = O_IP + (size_t)NL * NB * NG * NP, O_VS = O_KS + (size_t)NL * MS * DHALF, O_RS = O_VS + (size_t)NL * MS * DHALF,
                 O_IS = O_RS + (size_t)NL * NB * NG * NP, O_END = O_IS + (size_t)NL * NB * NG * NP;

constexpr size_t MiB = 1u << 20;
constexpr size_t WS_CTL = 0;
constexpr size_t WS_SS = 1 * MiB, CTL_ZERO_BYTES = 3 * MiB;
constexpr size_t WS_PAR = 3 * MiB;
constexpr size_t WS_ABAR = WS_PAR, WS_BBF = WS_PAR + 64 * 1024, WS_CBF = WS_BBF + 512 * 1024;
constexpr size_t WS_WIN = 5 * MiB;
constexpr size_t WS_WOUT = 29 * MiB;
constexpr size_t WS_WGLU = 37 * MiB;
constexpr size_t WS_X = 40 * MiB;
constexpr size_t WS_XB = WS_X + 258 * MiB;
constexpr size_t WS_Q = WS_XB + 129 * MiB;
constexpr size_t WS_KT = WS_Q + 65 * MiB;
constexpr size_t WS_VT = WS_KT + 64 * MiB;
constexpr size_t WS_GA = WS_VT + 64 * MiB;
constexpr size_t WS_U = WS_GA + 65 * MiB;
constexpr size_t WS_GS = WS_U + 65 * MiB;
constexpr size_t WS_ATT = WS_GS + 65 * MiB;
constexpr size_t WS_YPRE = WS_ATT + 65 * MiB;
constexpr size_t WS_SSMY = WS_YPRE + 65 * MiB;
constexpr size_t WS_CAT = WS_SSMY + 65 * MiB;
constexpr size_t WS_END = WS_CAT + 129 * MiB;
constexpr int CW_BAR = 4096;

constexpr int RING_BYTES = 131072;
constexpr int ENDS_OFF = 65536;
constexpr int LDSCTL_OFF = RING_BYTES, MISC_OFF = LDSCTL_OFF + 320;
constexpr int LDS_BYTES = 147456;

typedef float f32x2 __attribute__((ext_vector_type(2)));
typedef float f32x16 __attribute__((ext_vector_type(16)));
typedef __bf16 bf16x2_t __attribute__((ext_vector_type(2)));
typedef short s16x4 __attribute__((ext_vector_type(4)));
__device__ __forceinline__ unsigned cvtpk(float lo, float hi) { f32x2 v = {lo, hi}; bf16x2_t b = __builtin_convertvector(v, bf16x2_t); return __builtin_bit_cast(unsigned, b); }
__device__ __forceinline__ bf16x8 pack8(f32x4 a, f32x4 b) { v4u w; w.x = cvtpk(a[0], a[1]); w.y = cvtpk(a[2], a[3]); w.z = cvtpk(b[0], b[1]); w.w = cvtpk(b[2], b[3]); return __builtin_bit_cast(bf16x8, w); }
__device__ __forceinline__ float bf2f(unsigned short b) { return __builtin_bit_cast(float, (unsigned)b << 16); }
__device__ __forceinline__ float ex2(float x) { return __builtin_amdgcn_exp2f(x); }
__device__ __forceinline__ float rcp(float x) { return __builtin_amdgcn_rcpf(x); }
__device__ __forceinline__ float silu_f(float v) { return v * rcp(1.f + ex2(-LOG2E * v)); }
__device__ __forceinline__ float sigm_f(float v) { return rcp(1.f + ex2(-LOG2E * v)); }
__device__ __forceinline__ float gelu_tanh_f(float y) {
    const float a2 = y * (1.5957691216f + 0.0713548163f * y * y);
    return y * rcp(1.f + ex2(-LOG2E * a2));
}
__device__ __forceinline__ float wave_sum(float v) {
#pragma unroll
    for (int o = 1; o < 64; o <<= 1) v += __shfl_xor(v, o);
    return v;
}
typedef short v4i16_t __attribute__((ext_vector_type(4)));
__device__ __forceinline__ s16x4 vtr(const LAS unsigned char* p) { return __builtin_bit_cast(s16x4, __builtin_amdgcn_ds_read_tr16_b64_v4i16((LAS v4i16_t*)p)); }
#define MFMA32(a, b, c) __builtin_amdgcn_mfma_f32_32x32x16_bf16((a), (b), (c), 0, 0, 0)
#define MFMA16(a, b, c) __builtin_amdgcn_mfma_f32_16x16x32_bf16((a), (b), (c), 0, 0, 0)

struct EpiProj {
    static constexpr bool PERM = true, AFTER_DRAIN = false;
    unsigned char* ws_; float* out_; int l;
    __device__ __forceinline__ void operator()(const pg8::f32x4 (&acc)[2][2][4][2], const pg8::Unit& u, int wr, int wc, int fr, int fq) const {
        GAS unsigned char* wg_ = (GAS unsigned char*)ws_; GAS float* og_ = (GAS float*)out_; asm volatile("" : "+s"(wg_), "+s"(og_)); unsigned char* const w = (unsigned char*)wg_; float* const o = (float*)og_;
        const float* ss = (const float*)(w + WS_SS) + (size_t)l * MT;
        bf16* Q = (bf16*)(w + WS_Q); unsigned char* KT = w + WS_KT; unsigned char* VT = w + WS_VT; bf16* GA = (bf16*)(w + WS_GA); bf16* U = (bf16*)(w + WS_U); bf16* GS = (bf16*)(w + WS_GS);
        float* kp = o + O_KP + (size_t)l * MP * DHALF; float* vp = o + O_VP + (size_t)l * MP * DHALF; float* ks = o + O_KS + (size_t)l * MS * DHALF; float* vs = o + O_VS + (size_t)l * MS * DHALF;
        const int typ = u.pn >> 1;
        const int csb = (u.pn & 1) * 256 + wc * 32 + 8 * fq;
        const int rowb = u.pm * 256 + wr * 64 + fr;
        float rs[2][4];
#pragma unroll
        for (int ai = 0; ai < 2; ++ai)
#pragma unroll
            for (int m = 0; m < 4; ++m) rs[ai][m] = ss[rowb + ai * 128 + m * 16];
#pragma unroll
        for (int ai = 0; ai < 2; ++ai)
#pragma unroll
            for (int m = 0; m < 4; ++m) rs[ai][m] = 1.0f / sqrtf(rs[ai][m] * (1.0f / DM) + EPS);
        if (typ == 0) {
#pragma unroll
            for (int ai = 0; ai < 2; ++ai)
#pragma unroll
                for (int m = 0; m < 4; ++m) { const int row = rowb + ai * 128 + m * 16; const float s = rs[ai][m] * QSCALE;
#pragma unroll
                    for (int bj = 0; bj < 2; ++bj) { const int cs = csb + bj * 128;
                        *(v4u*)(Q + (size_t)row * DHALF + cs) = __builtin_bit_cast(v4u, pack8(acc[ai][bj][m][0] * s, acc[ai][bj][m][1] * s)); } }
        } else if (typ == 1 || typ == 2) {
            const bool isk = (typ == 1); const bool prompt = (u.pm < MP / 256);
            float* of = prompt ? (isk ? kp : vp) : (isk ? ks : vs);
            unsigned char* tb = isk ? KT : VT;
#pragma unroll
            for (int ai = 0; ai < 2; ++ai)
#pragma unroll
                for (int m = 0; m < 4; ++m) { const int row = rowb + ai * 128 + m * 16; const float s = rs[ai][m];
                    const int orow = prompt ? row : row - MP;
#pragma unroll
                    for (int bj = 0; bj < 2; ++bj) { const int cs = csb + bj * 128;
                        const f32x4 v0 = acc[ai][bj][m][0] * s, v1 = acc[ai][bj][m][1] * s;
                        float* op = of + (size_t)orow * DHALF + cs; *(f32x4*)op = v0; *(f32x4*)(op + 4) = v1;
                        if (prompt) { const int b = row >> 12, t = row & 4095, hd = cs >> 6, ch = (cs & 63) >> 3;
                            const size_t tile = ((size_t)(b * NH + hd) * 64 + (t >> 6)) * 8192;
                            const size_t off = isk ? tile + ch * 1024 + (t & 63) * 16 : tile + (ch >> 2) * 4096 + (t & 63) * 64 + (ch & 3) * 16;
                            *(v4u*)(tb + off) = __builtin_bit_cast(v4u, pack8(v0, v1)); } } }
        } else {
            bf16* ob = (typ == 3) ? GA : (typ == 4) ? U : GS; const bool act = (typ != 4);
#pragma unroll
            for (int ai = 0; ai < 2; ++ai)
#pragma unroll
                for (int m = 0; m < 4; ++m) { const int row = rowb + ai * 128 + m * 16; const float s = rs[ai][m];
#pragma unroll
                    for (int bj = 0; bj < 2; ++bj) { const int cs = csb + bj * 128;
                        f32x4 v0 = acc[ai][bj][m][0] * s, v1 = acc[ai][bj][m][1] * s;
                        if (act) {
#pragma unroll
                            for (int e = 0; e < 4; ++e) { v0[e] = silu_f(v0[e]); v1[e] = silu_f(v1[e]); } }
                        *(v4u*)(ob + (size_t)row * DHALF + cs) = __builtin_bit_cast(v4u, pack8(v0, v1)); } }
        }
    }
};
struct EpiGlu {
    static constexpr bool PERM = true, AFTER_DRAIN = false;
    unsigned char* ws_; const float* bias;
    __device__ __forceinline__ void operator()(const pg8::f32x4 (&acc)[2][2][4][2], const pg8::Unit& u, int wr, int wc, int fr, int fq) const {
        GAS unsigned char* wg_ = (GAS unsigned char*)ws_; asm volatile("" : "+s"(wg_)); unsigned char* const w = (unsigned char*)wg_;
        const bf16* Y = (const bf16*)(w + WS_YPRE); bf16* O = (bf16*)(w + WS_SSMY);
        const int cb = u.pn * 256 + wc * 32 + 8 * fq, rowb = u.pm * 256 + wr * 64 + fr;
        f32x4 bv[2][2];
#pragma unroll
        for (int bj = 0; bj < 2; ++bj) { bv[bj][0] = *(const f32x4*)(bias + cb + bj * 128); bv[bj][1] = *(const f32x4*)(bias + cb + bj * 128 + 4); }
#pragma unroll
        for (int ai = 0; ai < 2; ++ai) {
            v4u ywv[4][2];
#pragma unroll
            for (int m = 0; m < 4; ++m)
#pragma unroll
                for (int bj = 0; bj < 2; ++bj) ywv[m][bj] = *(const v4u*)(Y + (size_t)(rowb + ai * 128 + m * 16) * DHALF + cb + bj * 128);
            asm volatile("" ::: "memory");
#pragma unroll
            for (int m = 0; m < 4; ++m) { const int row = rowb + ai * 128 + m * 16;
#pragma unroll
                for (int bj = 0; bj < 2; ++bj) { const int c = cb + bj * 128;
                    const v4u yw = ywv[m][bj];
                    f32x4 v0 = acc[ai][bj][m][0] + bv[bj][0], v1 = acc[ai][bj][m][1] + bv[bj][1];
#pragma unroll
                    for (int e = 0; e < 4; ++e) { const unsigned w0 = yw[e >> 1], w1 = yw[2 + (e >> 1)];
                        const float y0 = (e & 1) ? __builtin_bit_cast(float, w0 & 0xffff0000u) : __builtin_bit_cast(float, w0 << 16);
                        const float y1 = (e & 1) ? __builtin_bit_cast(float, w1 & 0xffff0000u) : __builtin_bit_cast(float, w1 << 16);
                        v0[e] = y0 * sigm_f(v0[e]); v1[e] = y1 * sigm_f(v1[e]); }
                    *(v4u*)(O + (size_t)row * DHALF + c) = __builtin_bit_cast(v4u, pack8(v0, v1)); } }
        }
    }
};
struct EpiOut {
    static constexpr bool PERM = true, AFTER_DRAIN = false;
    unsigned char* ws_; int l;
    __device__ __forceinline__ void operator()(const pg8::f32x4 (&acc)[2][2][4][2], const pg8::Unit& u, int wr, int wc, int fr, int fq) const {
        GAS unsigned char* wg_ = (GAS unsigned char*)ws_; asm volatile("" : "+s"(wg_)); unsigned char* const w = (unsigned char*)wg_;
        float* X = (float*)(w + WS_X); bf16* XB = (bf16*)(w + WS_XB); float* ssn = (float*)(w + WS_SS) + (size_t)(l + 1) * MT;
        const bool last = (l == NL - 1);
        const int cb = u.pn * 256 + wc * 32 + 8 * fq, rowb = u.pm * 256 + wr * 64 + fr;
#pragma unroll
        for (int ai = 0; ai < 2; ++ai) {
            v4u xv[4][2];
#pragma unroll
            for (int m = 0; m < 4; ++m)
#pragma unroll
                for (int bj = 0; bj < 2; ++bj) xv[m][bj] = *(const v4u*)(XB + (size_t)(rowb + ai * 128 + m * 16) * DM + cb + bj * 128);
            asm volatile("" ::: "memory");
#pragma unroll
            for (int m = 0; m < 4; ++m) { const int row = rowb + ai * 128 + m * 16;
                float sq = 0.f;
#pragma unroll
                for (int bj = 0; bj < 2; ++bj) { const int c = cb + bj * 128; const v4u xw = xv[m][bj];
                    f32x4 v0 = acc[ai][bj][m][0], v1 = acc[ai][bj][m][1];
#pragma unroll
                    for (int e = 0; e < 4; ++e) { const unsigned w0 = xw[e >> 1], w1 = xw[2 + (e >> 1)];
                        v0[e] += (e & 1) ? __builtin_bit_cast(float, w0 & 0xffff0000u) : __builtin_bit_cast(float, w0 << 16);
                        v1[e] += (e & 1) ? __builtin_bit_cast(float, w1 & 0xffff0000u) : __builtin_bit_cast(float, w1 << 16); }
                    if (last) { float* xo = X + (size_t)row * DM + c; *(f32x4*)xo = v0; *(f32x4*)(xo + 4) = v1; }
                    else *(v4u*)(XB + (size_t)row * DM + c) = __builtin_bit_cast(v4u, pack8(v0, v1));
                    sq += (v0[0] * v0[0] + v0[1] * v0[1]) + (v0[2] * v0[2] + v0[3] * v0[3]) + (v1[0] * v1[0] + v1[1] * v1[1]) + (v1[2] * v1[2] + v1[3] * v1[3]); }
                sq += __shfl_xor(sq, 16); sq += __shfl_xor(sq, 32);
                if (fq == 0) unsafeAtomicAdd(ssn + row, sq); }
            asm volatile("" ::: "memory");
        }
    }
};

template <bool SAMPLE>
__device__ __forceinline__ void attn_tile(LAS unsigned char* vl, const int lane, const int t0, const int hmax,
                                          const bf16* __restrict__ Qp, const unsigned char* __restrict__ Kt, const unsigned char* __restrict__ Vt,
                                          const float* __restrict__ Kc, const float* __restrict__ Vc, const float* __restrict__ Kn, const float* __restrict__ Vn,
                                          bf16* __restrict__ Op) {
    const int q = lane & 31, h = lane >> 5;
    const int qpos = t0 + q;
    bf16x8 qf[4];
#pragma unroll
    for (int ds = 0; ds < 4; ++ds) qf[ds] = *(const bf16x8*)(Qp + (size_t)q * DHALF + ds * 16 + h * 8);
    const int kslot = 16 * ((q >> 2) & 1) + (q & 3) + 4 * (q >> 3);
    const int mg = (lane >> 4) & 1, qq = (lane >> 2) & 3, pp = lane & 3;
    const int trb = (16 * h + qq) * 64 + (16 * (pp & 1) + 8 * mg + 4 * (pp >> 1)) * 2;
    f32x16 o0, o1;
#pragma unroll
    for (int r = 0; r < 16; ++r) { o0[r] = 0.f; o1[r] = 0.f; }
    float C = 1.f;
    bf16x8 kf[4]; v4u vr[4];
#define LOAD_K(hb_) do { const int hb2_ = (hb_); \
        if constexpr (!SAMPLE) { \
            const unsigned char* kb_ = Kt + (size_t)(hb2_ >> 1) * 8192 + h * 1024 + (32 * (hb2_ & 1) + kslot) * 16; \
            _Pragma("unroll") for (int ds = 0; ds < 4; ++ds) kf[ds] = *(const bf16x8*)(kb_ + ds * 2048); \
        } else { \
            const int pos_ = 32 * hb2_ + kslot; \
            const float* src_ = (pos_ < PAST) ? Kc + (size_t)pos_ * DHALF : Kn + (size_t)(pos_ - PAST) * DHALF; \
            _Pragma("unroll") for (int ds = 0; ds < 4; ++ds) { const f32x4 a_ = *(const f32x4*)(src_ + ds * 16 + h * 8), b_ = *(const f32x4*)(src_ + ds * 16 + h * 8 + 4); kf[ds] = pack8(a_, b_); } \
        } } while (0)
#define LOAD_V(hb_) do { const int hb2_ = (hb_); \
        if constexpr (!SAMPLE) { \
            const unsigned char* vb_ = Vt + (size_t)(hb2_ >> 1) * 8192 + (hb2_ & 1) * 2048 + lane * 16; \
            _Pragma("unroll") for (int it = 0; it < 4; ++it) vr[it] = *(const v4u*)(vb_ + (it >> 1) * 4096 + (it & 1) * 1024); \
        } else { \
            _Pragma("unroll") for (int it = 0; it < 4; ++it) { const int pos_ = 32 * hb2_ + it * 8 + (lane >> 3); \
                const float* src_ = ((pos_ < PAST) ? Vc + (size_t)pos_ * DHALF : Vn + (size_t)(pos_ - PAST) * DHALF) + (lane & 7) * 8; \
                const f32x4 a_ = *(const f32x4*)src_, b_ = *(const f32x4*)(src_ + 4); vr[it] = __builtin_bit_cast(v4u, pack8(a_, b_)); } \
        } } while (0)
    LOAD_K(hmax); LOAD_V(hmax);
    for (int hb = hmax;; --hb) {
        f32x16 p;
#pragma unroll
        for (int r = 0; r < 16; ++r) p[r] = 0.f;
#pragma unroll
        for (int ds = 0; ds < 4; ++ds) p = MFMA32(kf[ds], qf[ds], p);
        if constexpr (!SAMPLE) {
#pragma unroll
            for (int it = 0; it < 4; ++it) *(LAS v4u*)(vl + (it >> 1) * 2048 + (it & 1) * 1024 + lane * 16) = vr[it];
        } else {
#pragma unroll
            for (int it = 0; it < 4; ++it) { const int key = it * 8 + (lane >> 3), ch = lane & 7; *(LAS v4u*)(vl + (ch >> 2) * 2048 + key * 64 + (ch & 3) * 16) = vr[it]; }
        }
        if constexpr (!SAMPLE) { if (hb > 0) { LOAD_K(hb - 1); LOAD_V(hb - 1); } }
        const int kb0 = 32 * hb + 16 * h;
        if (32 * hb + 31 >= t0) {
#pragma unroll
            for (int r = 0; r < 16; ++r) if (kb0 + r >= qpos) p[r] = -INFINITY;
        }
#pragma unroll
        for (int r = 0; r < 16; ++r) p[r] = rcp(1.f + ex2(p[r]));
        float T = p[0] * p[1];
#pragma unroll
        for (int r = 2; r < 16; ++r) T *= p[r];
        const float Tp = __shfl_xor(T, 32);
        float E = h ? C : C * Tp;
        C = C * (T * Tp);
#pragma unroll
        for (int r = 15; r >= 0; --r) { const float rr = p[r]; p[r] = __builtin_fmaf(-rr, E, E); E *= rr; }
        bf16x8 w[2];
        { v4u t;
          t.x = cvtpk(p[0], p[1]); t.y = cvtpk(p[2], p[3]); t.z = cvtpk(p[4], p[5]); t.w = cvtpk(p[6], p[7]); w[0] = __builtin_bit_cast(bf16x8, t);
          t.x = cvtpk(p[8], p[9]); t.y = cvtpk(p[10], p[11]); t.z = cvtpk(p[12], p[13]); t.w = cvtpk(p[14], p[15]); w[1] = __builtin_bit_cast(bf16x8, t); }
        asm volatile("" ::: "memory");
#pragma unroll
        for (int s = 0; s < 2; ++s) {
            const LAS unsigned char* vp = vl + trb + s * 512;
            const s16x4 a0l = vtr(vp), a0h = vtr(vp + 256), a1l = vtr(vp + 2048), a1h = vtr(vp + 2048 + 256);
            const bf16x8 A0 = {a0l[0], a0l[1], a0l[2], a0l[3], a0h[0], a0h[1], a0h[2], a0h[3]};
            const bf16x8 A1 = {a1l[0], a1l[1], a1l[2], a1l[3], a1h[0], a1h[1], a1h[2], a1h[3]};
            o0 = MFMA32(A0, w[s], o0); o1 = MFMA32(A1, w[s], o1);
        }
        asm volatile("" ::: "memory");
        if (hb == 0) break;
        if (__all(C < EXIT_THR)) break;
        if constexpr (SAMPLE) { LOAD_K(hb - 1); LOAD_V(hb - 1); }
    }
    bf16* op = Op + (size_t)q * DHALF + 16 * h;
    { f32x4 a = {o0[0], o0[1], o0[2], o0[3]}, b = {o0[4], o0[5], o0[6], o0[7]}, c = {o0[8], o0[9], o0[10], o0[11]}, d = {o0[12], o0[13], o0[14], o0[15]};
      *(v4u*)op = __builtin_bit_cast(v4u, pack8(a, b)); *(v4u*)(op + 8) = __builtin_bit_cast(v4u, pack8(c, d)); }
    { f32x4 a = {o1[0], o1[1], o1[2], o1[3]}, b = {o1[4], o1[5], o1[6], o1[7]}, c = {o1[8], o1[9], o1[10], o1[11]}, d = {o1[12], o1[13], o1[14], o1[15]};
      *(v4u*)(op + 32) = __builtin_bit_cast(v4u, pack8(a, b)); *(v4u*)(op + 40) = __builtin_bit_cast(v4u, pack8(c, d)); }
}
#undef LOAD_K
#undef LOAD_V

template <bool PASS2>
__device__ __forceinline__ void ssm_pass(LAS unsigned char* vl, const int lane, const int g, const bf16* __restrict__ U, bf16* __restrict__ Y,
                                         const int sbase0, const int sbase1, const int nsteps,
                                         const bf16x8 (&bre)[2], const bf16x8 (&bim)[2], const float (&ar)[2], const float (&ai)[2],
                                         const bf16x8 (&cf)[4], const bf16x8 df, float (&sr)[2], float (&si)[2]) {
    const int m = lane & 31, kh = lane >> 5;
    const int sm = (m >> 2) & 1, tok = (m & 3) + 4 * (m >> 3);
    const bf16* up = U + (size_t)((sm ? sbase1 : sbase0) + tok) * DHALF + g * NC + kh * 8;
    const int tk = lane & 15, kg = lane >> 4, qq = (lane >> 2) & 3, pp = lane & 3;
    const bf16* ud0 = U + (size_t)(sbase0 + tk) * DHALF + g * NC + (kg & 1) * 8;
    const bf16* ud1 = U + (size_t)(sbase1 + tk) * DHALF + g * NC + (kg & 1) * 8;
    bf16x8 uf_n = *(const bf16x8*)up;
    v4u uw_n[2] = {(v4u){0u, 0u, 0u, 0u}, (v4u){0u, 0u, 0u, 0u}};
    if constexpr (PASS2) { uw_n[0] = *(const v4u*)ud0; uw_n[1] = *(const v4u*)ud1; }
    for (int step = 0; step < nsteps; ++step) {
        const bf16x8 uf = *(const bf16x8*)(up + (size_t)step * 16 * DHALF); v4u uw0 = uw_n[0], uw1 = uw_n[1];
        if constexpr (PASS2) { uw0 = *(const v4u*)(ud0 + (size_t)step * 16 * DHALF); uw1 = *(const v4u*)(ud1 + (size_t)step * 16 * DHALF); }
        f32x16 z;
#pragma unroll
        for (int r = 0; r < 16; ++r) z[r] = 0.f;
        f32x16 br[2], bi[2];
#pragma unroll
        for (int pt = 0; pt < 2; ++pt) { br[pt] = MFMA32(uf, bre[pt], z); bi[pt] = MFMA32(uf, bim[pt], z); }
#pragma unroll
        for (int pt = 0; pt < 2; ++pt)
#pragma unroll
            for (int r = 0; r < 16; ++r) {
                const float nr = __builtin_fmaf(ar[pt], sr[pt], __builtin_fmaf(-ai[pt], si[pt], br[pt][r]));
                const float ni = __builtin_fmaf(ar[pt], si[pt], __builtin_fmaf(ai[pt], sr[pt], bi[pt][r]));
                sr[pt] = nr; si[pt] = ni;
                if constexpr (PASS2) { br[pt][r] = nr; bi[pt][r] = ni; }
            }
        if constexpr (PASS2) {
#pragma unroll
            for (int pt = 0; pt < 2; ++pt) {
                LAS unsigned char* wre = vl + kh * 4096 + (m + 32 * pt) * 32;
                LAS unsigned char* wim = wre + 64 * 32;
                { f32x4 a = {br[pt][0], br[pt][1], br[pt][2], br[pt][3]}, b = {br[pt][4], br[pt][5], br[pt][6], br[pt][7]}, c = {br[pt][8], br[pt][9], br[pt][10], br[pt][11]}, d = {br[pt][12], br[pt][13], br[pt][14], br[pt][15]};
                  *(LAS v4u*)wre = __builtin_bit_cast(v4u, pack8(a, b)); *(LAS v4u*)(wre + 16) = __builtin_bit_cast(v4u, pack8(c, d)); }
                { f32x4 a = {bi[pt][0], bi[pt][1], bi[pt][2], bi[pt][3]}, b = {bi[pt][4], bi[pt][5], bi[pt][6], bi[pt][7]}, c = {bi[pt][8], bi[pt][9], bi[pt][10], bi[pt][11]}, d = {bi[pt][12], bi[pt][13], bi[pt][14], bi[pt][15]};
                  *(LAS v4u*)wim = __builtin_bit_cast(v4u, pack8(a, b)); *(LAS v4u*)(wim + 16) = __builtin_bit_cast(v4u, pack8(c, d)); }
            }
            asm volatile("" ::: "memory");
#pragma unroll
            for (int s = 0; s < 2; ++s) {
                pg8::f32x4 y = {0.f, 0.f, 0.f, 0.f};
                const LAS unsigned char* hp = vl + s * 4096 + (8 * kg + qq) * 32 + pp * 8;
#pragma unroll
                for (int ks = 0; ks < 4; ++ks) {
                    const s16x4 lo = vtr(hp + ks * 32 * 32), hi = vtr(hp + ks * 32 * 32 + 4 * 32);
                    const bf16x8 hf = {lo[0], lo[1], lo[2], lo[3], hi[0], hi[1], hi[2], hi[3]};
                    y = MFMA16(cf[ks], hf, y);
                }
                const size_t trow = (size_t)((s ? sbase1 : sbase0) + step * 16 + tk);
                v4u uw = s ? uw1 : uw0;
                if (kg >= 2) uw = (v4u){0u, 0u, 0u, 0u};
                y = MFMA16(df, __builtin_bit_cast(bf16x8, uw), y);
                uint2 o; o.x = cvtpk(gelu_tanh_f(y[0]), gelu_tanh_f(y[1])); o.y = cvtpk(gelu_tanh_f(y[2]), gelu_tanh_f(y[3]));
                *(uint2*)(Y + trow * DHALF + g * NC + 4 * kg) = o;
            }
            asm volatile("" ::: "memory");
        }
    }
}
struct SsmPar { bf16x8 bre[2], bim[2]; float ar[2], ai[2]; };
__device__ __forceinline__ void ssm_load_par(SsmPar& P, const float* ABAR, const bf16* BBF, int l, int g, int lane) {
    const int p = lane & 31, kh = lane >> 5;
#pragma unroll
    for (int pt = 0; pt < 2; ++pt) {
        const f32x2 a = *(const f32x2*)(ABAR + ((size_t)(l * NG + g) * NP + p + 32 * pt) * 2); P.ar[pt] = a.x; P.ai[pt] = a.y;
        P.bre[pt] = *(const bf16x8*)(BBF + (((size_t)(l * NG + g) * 2 + 0) * NP + p + 32 * pt) * NC + kh * 8);
        P.bim[pt] = *(const bf16x8*)(BBF + (((size_t)(l * NG + g) * 2 + 1) * NP + p + 32 * pt) * NC + kh * 8);
    }
}
__device__ __forceinline__ void ssm_load_cd(bf16x8 (&cf)[4], bf16x8& df, const bf16* CBF, const float* dsk, int l, int g, int lane) {
    const int c = lane & 15, kg = lane >> 4;
#pragma unroll
    for (int ks = 0; ks < 4; ++ks) cf[ks] = *(const bf16x8*)(CBF + ((size_t)(l * NG + g) * NC + c) * (2 * NP) + 32 * ks + 8 * kg);
    const float dv = dsk[(size_t)l * DHALF + g * NC + c];
    const unsigned short db = (unsigned short)(cvtpk(dv, 0.f) & 0xffffu);
#pragma unroll
    for (int j = 0; j < 8; ++j) df[j] = (short)((kg < 2 && 8 * kg + j == c) ? db : 0);
}
struct Args { const float* in[22]; float* out; unsigned char* ws; };
enum { I_XP = 0, I_XS, I_CK, I_CV, I_SR, I_SI, I_LNG, I_WIN, I_ARE, I_AIM, I_LDT, I_BRE, I_BIM, I_CRE, I_CIM, I_D, I_WGLU, I_BGLU, I_GATT, I_GSSM, I_WOUT, I_FG };

__device__ __forceinline__ void transpose_item(const float* W, int K, int N, bf16* WT, const float* kscale, LAS float* scr, int item, int lane) {
    const int nblk = N / 32, kb = item / nblk, nb = item % nblk, k0 = 64 * kb, n0 = 32 * nb;
#pragma unroll 8
    for (int i = 0; i < 32; ++i) { const int kk = 2 * i + (lane >> 5); float v = W[(size_t)(k0 + kk) * N + n0 + (lane & 31)]; if (kscale) v *= kscale[k0 + kk]; scr[kk * 33 + (lane & 31)] = v; }
    LDS_WAIT(); asm volatile("" ::: "memory");
    const int c = lane & 7;
#pragma unroll
    for (int j = 0; j < 4; ++j) { const int n = (lane >> 3) + 8 * j; const LAS float* s = scr + (8 * c) * 33 + n;
        v4u o; o.x = cvtpk(s[0 * 33], s[1 * 33]); o.y = cvtpk(s[2 * 33], s[3 * 33]); o.z = cvtpk(s[4 * 33], s[5 * 33]); o.w = cvtpk(s[6 * 33], s[7 * 33]);
        *(v4u*)(WT + (size_t)(n0 + n) * K + k0 + 8 * c) = o; }
    LDS_WAIT(); asm volatile("" ::: "memory");
}

constexpr int TBL_OFF = LDSCTL_OFF + 1024;
constexpr int REP_P1 = 1, REP_P2 = 1, REP_P3 = 1, REP_P4 = 1;
__device__ __forceinline__ void stagger(int c, int n_extra, unsigned unit_ticks) {
    if (c < n_extra) return;
    const unsigned d = (unsigned)((c * 37) & 255) * unit_ticks / 256u;
    const unsigned long long t0 = rt();
    while ((unsigned long long)(rt() - t0) < d) __builtin_amdgcn_s_sleep(16);
}
__device__ __forceinline__ const float* inptr(LAS unsigned char* lds, int i) {
    const unsigned long long v = *(volatile LAS unsigned long long*)(lds + TBL_OFF + 8 * i);
    const unsigned lo = __builtin_amdgcn_readfirstlane((unsigned)v), hi = __builtin_amdgcn_readfirstlane((unsigned)(v >> 32));
    return (const float*)(GAS const float*)(((unsigned long long)hi << 32) | lo);
}
__global__ void __launch_bounds__(NWAVES * 64, 2) hymba_fwd(Args args) {
    extern __shared__ __attribute__((aligned(16))) unsigned char lds_raw[];
    LAS unsigned char* lds = (LAS unsigned char*)lds_raw;
    volatile LAS unsigned* MISC = (volatile LAS unsigned*)(lds + MISC_OFF);
    const int tid = threadIdx.x, lane0 = tid & 63, wave = __builtin_amdgcn_readfirstlane(tid >> 6);
    const int G = gridDim.x, bid = blockIdx.x;
    unsigned char* const ws = args.ws;
    float* const out = args.out;
    for (int u = tid; u < (LDS_BYTES - LDSCTL_OFF) / 4; u += NWAVES * 64) ((LAS unsigned*)(lds + LDSCTL_OFF))[u] = 0u;
    __syncthreads();
    if (tid < 22) *(LAS unsigned long long*)(lds + TBL_OFF + 8 * tid) = (unsigned long long)args.in[tid];
    __syncthreads();
    XcdBarrier bar = xcd_barrier_post((unsigned*)(ws + WS_CTL) + CW_BAR, MISC + 8);
    const int gw = bid * NWAVES + wave, NGW = G * NWAVES;
    LAS unsigned char* wl = lds + wave * 8192;
#define INP(i) inptr(lds, (i))
#define LNL int lane = lane0; asm volatile("" : "+v"(lane))
#define WSL(name) GAS unsigned char* name##_g = (GAS unsigned char*)ws; asm volatile("" : "+s"(name##_g)); unsigned char* const name = (unsigned char*)name##_g

#ifndef SKIP_P0
    {
        LAS float* scr = (LAS float*)(lds + wave * 16384);
        WSL(w); LNL;
        float* SS = (float*)(w + WS_SS); float* ABAR = (float*)(w + WS_ABAR); bf16* BBF = (bf16*)(w + WS_BBF); bf16* CBF = (bf16*)(w + WS_CBF);
        bf16* WIN = (bf16*)(w + WS_WIN); bf16* WOUT = (bf16*)(w + WS_WOUT); bf16* WGLU = (bf16*)(w + WS_WGLU); bf16* XB = (bf16*)(w + WS_XB);
        constexpr int I_IN = (DM / 64) * (DIN / 32), I_OUT = (DM / 64) * (DM / 32), I_GLU = (DHALF / 64) * (DHALF / 32);
        constexpr int PER_L = I_IN + I_OUT + I_GLU, NITEMS = NL * PER_L;
        for (int it = gw; it < NITEMS; it += NGW) {
            const int l = it / PER_L; int r = it % PER_L;
            if (r < I_IN) { transpose_item(INP(I_WIN) + (size_t)l * DM * DIN, DM, DIN, WIN + (size_t)l * DIN * DM, INP(I_LNG) + (size_t)l * DM, scr, r, lane); continue; } r -= I_IN;
            if (r < I_OUT) { transpose_item(INP(I_WOUT) + (size_t)l * DM * DM, DM, DM, WOUT + (size_t)l * DM * DM, nullptr, scr, r, lane); continue; } r -= I_OUT;
            transpose_item(INP(I_WGLU) + (size_t)l * DHALF * DHALF, DHALF, DHALF, WGLU + (size_t)l * DHALF * DHALF, nullptr, scr, r, lane);
        }
        for (int i = bid * (NWAVES * 64) + tid; i < NL * NG * NP; i += G * NWAVES * 64) {
            const int p = i % NP, lg = i / NP;
            const float dt = expf(INP(I_LDT)[lg]);
            const float are = INP(I_ARE)[i], aim = INP(I_AIM)[i];
            const float mag = expf(are * dt), ang = aim * dt;
            const float abr = mag * cosf(ang), abi = mag * sinf(ang);
            const float den = are * are + aim * aim;
            const float fre = ((abr - 1.0f) * are + abi * aim) / den, fim = (abi * are - (abr - 1.0f) * aim) / den;
            ABAR[(size_t)i * 2] = abr; ABAR[(size_t)i * 2 + 1] = abi;
            const float* bre = INP(I_BRE) + (size_t)i * NC; const float* bim = INP(I_BIM) + (size_t)i * NC;
#pragma unroll
            for (int c = 0; c < NC; c += 2) {
                const float r0 = fre * bre[c] - fim * bim[c], i0 = fre * bim[c] + fim * bre[c];
                const float r1 = fre * bre[c + 1] - fim * bim[c + 1], i1 = fre * bim[c + 1] + fim * bre[c + 1];
                *(unsigned*)(BBF + (((size_t)lg * 2 + 0) * NP + p) * NC + c) = cvtpk(r0, r1);
                *(unsigned*)(BBF + (((size_t)lg * 2 + 1) * NP + p) * NC + c) = cvtpk(i0, i1);
            }
            const float* cre = INP(I_CRE); const float* cim = INP(I_CIM);
#pragma unroll
            for (int c = 0; c < NC; ++c) {
                const float cr = cre[((size_t)lg * NC + c) * NP + p], ci = cim[((size_t)lg * NC + c) * NP + p];
                CBF[((size_t)lg * NC + c) * (2 * NP) + p] = (bf16)(cvtpk(cr, 0.f) & 0xffffu);
                CBF[((size_t)lg * NC + c) * (2 * NP) + NP + p] = (bf16)(cvtpk(-ci, 0.f) & 0xffffu);
            }
        }
        const float* xp = INP(I_XP); const float* xs = INP(I_XS);
        for (int row = gw; row < MT; row += NGW) {
            const float* xr = (row < MP) ? xp + (size_t)row * DM : xs + (size_t)(row - MP) * DM;
            float s = 0.f;
#pragma unroll
            for (int j = 0; j < 2; ++j) { const f32x4 a = *(const f32x4*)(xr + j * 512 + lane * 8), b = *(const f32x4*)(xr + j * 512 + lane * 8 + 4);
                s += (a[0] * a[0] + a[1] * a[1]) + (a[2] * a[2] + a[3] * a[3]) + (b[0] * b[0] + b[1] * b[1]) + (b[2] * b[2] + b[3] * b[3]);
                *(v4u*)(XB + (size_t)row * DM + j * 512 + lane * 8) = __builtin_bit_cast(v4u, pack8(a, b)); }
            s = wave_sum(s);
            if (lane == 0) SS[row] = s;
        }
    }
#endif
    xcd_barrier(bar);

    for (int l = 0; l < NL; ++l) {
#ifndef SKIP_P1
        for (int rep = 0; rep < REP_P1; ++rep)
        {
            WSL(w);
            pg8::Gemm g{(const bf16*)(w + WS_XB), (const bf16*)(w + WS_WIN) + (size_t)l * DIN * DM, MT, DIN, DM}; pg8::StaticOrder S; S.init(MT, DIN, G, bid);
            EpiProj E{ws, out, l};
            pg8::gemm_phase<EpiProj, pg8::StaticOrder, true, true>(lds, g, S, E);
        }
#endif
        xcd_barrier(bar);
#ifndef SKIP_P2
        for (int rep = 0; rep < REP_P2; ++rep)
        {
#ifndef SKIP_SSM
            for (int ui = bid; ui < NB * NG; ui += G) {
                const int b = ui >> 5, g = ui & 31;
                WSL(w); LNL;
                const float* ABAR = (const float*)(w + WS_ABAR); const bf16* BBF = (const bf16*)(w + WS_BBF); const bf16* CBF = (const bf16*)(w + WS_CBF); const bf16* UB = (const bf16*)(w + WS_U); bf16* YPRE = (bf16*)(w + WS_YPRE);
                SsmPar P; ssm_load_par(P, ABAR, BBF, l, g, lane);
                const int h = lane >> 5, p = lane & 31;
                const int sb0 = b * TP + (2 * wave) * 256, sb1 = sb0 + 256;
                float sr[2] = {0.f, 0.f}, si[2] = {0.f, 0.f};
                bf16x8 cf[4]; bf16x8 df;
#pragma unroll
                for (int ks = 0; ks < 4; ++ks) cf[ks] = (bf16x8){0, 0, 0, 0, 0, 0, 0, 0};
                df = (bf16x8){0, 0, 0, 0, 0, 0, 0, 0};
                ssm_pass<false>(wl, lane, g, UB, YPRE, sb0, sb1, 16, P.bre, P.bim, P.ar, P.ai, cf, df, sr, si);
                LAS f32x2* ends = (LAS f32x2*)(lds + ENDS_OFF);
#pragma unroll
                for (int pt = 0; pt < 2; ++pt) ends[(2 * wave + h) * NP + p + 32 * pt] = (f32x2){sr[pt], si[pt]};
                __syncthreads();
                const int myS = 2 * wave + h;
#pragma unroll
                for (int pt = 0; pt < 2; ++pt) {
                    float a2r = P.ar[pt], a2i = P.ai[pt];
#pragma unroll
                    for (int i = 0; i < 8; ++i) { const float t = a2r * a2r - a2i * a2i; a2i = 2.f * a2r * a2i; a2r = t; }
                    float cr = 0.f, ci = 0.f;
                    for (int s2 = 0; s2 < 15; ++s2) {
                        const f32x2 e = ends[s2 * NP + p + 32 * pt];
                        const float nr = a2r * cr - a2i * ci + e.x, ni = a2r * ci + a2i * cr + e.y;
                        if (s2 < myS) { cr = nr; ci = ni; }
                    }
                    sr[pt] = cr; si[pt] = ci;
                }
                ssm_load_cd(cf, df, CBF, INP(I_D), l, g, lane);
                ssm_pass<true>(wl, lane, g, UB, YPRE, sb0, sb1, 16, P.bre, P.bim, P.ar, P.ai, cf, df, sr, si);
                if (wave == NWAVES - 1 && h == 1) {
#pragma unroll
                    for (int pt = 0; pt < 2; ++pt) { const size_t o = ((size_t)(l * NB + b) * NG + g) * NP + p + 32 * pt; out[O_RP + o] = sr[pt]; out[O_IP + o] = si[pt]; }
                }
                __syncthreads();
            }
#endif
#ifndef SKIP_SSMS
            for (int g = G - 1 - bid; g >= 0 && g < NG; g += G) {
                WSL(w); LNL;
                const float* ABAR = (const float*)(w + WS_ABAR); const bf16* BBF = (const bf16*)(w + WS_BBF); const bf16* CBF = (const bf16*)(w + WS_CBF); const bf16* UB = (const bf16*)(w + WS_U); bf16* YPRE = (bf16*)(w + WS_YPRE);
                const float* isr = INP(I_SR); const float* isi = INP(I_SI);
                SsmPar P; ssm_load_par(P, ABAR, BBF, l, g, lane);
                const int h = lane >> 5, p = lane & 31, b = 2 * wave + h;
                float sr[2], si[2];
#pragma unroll
                for (int pt = 0; pt < 2; ++pt) { const size_t o = ((size_t)(l * NB + b) * NG + g) * NP + p + 32 * pt; sr[pt] = isr[o]; si[pt] = isi[o]; }
                bf16x8 cf[4]; bf16x8 df; ssm_load_cd(cf, df, CBF, INP(I_D), l, g, lane);
                ssm_pass<true>(wl, lane, g, UB, YPRE, MP + (2 * wave) * TSM, MP + (2 * wave + 1) * TSM, 2, P.bre, P.bim, P.ar, P.ai, cf, df, sr, si);
#pragma unroll
                for (int pt = 0; pt < 2; ++pt) { const size_t o = ((size_t)(l * NB + b) * NG + g) * NP + p + 32 * pt; out[O_RS + o] = sr[pt]; out[O_IS + o] = si[pt]; }
            }
#endif
#ifndef SKIP_ATT
            for (int c8 = bid; c8 < MP / 256; c8 += G) {
                WSL(w); LNL;
                const bf16* QB = (const bf16*)(w + WS_Q); const unsigned char* KT = w + WS_KT; const unsigned char* VT = w + WS_VT; bf16* ATT = (bf16*)(w + WS_ATT);
                for (int uu = 0; uu < 8; ++uu) {
                    const int unit = c8 * 8 + uu, b = unit >> 7, t0 = (unit & 127) * 32, row0 = b * TP + t0;
                    const size_t hb = (size_t)(b * NH + wave) * 64 * 8192;
                    attn_tile<false>(wl, lane, t0, (t0 + 30) >> 5, QB + (size_t)row0 * DHALF + wave * HD, KT + hb, VT + hb, nullptr, nullptr, nullptr, nullptr, ATT + (size_t)row0 * DHALF + wave * HD);
                }
            }
#endif
#ifndef SKIP_ATTS
            for (int b = bid; b < NB; b += G) {
                WSL(w); LNL;
                const bf16* QB = (const bf16*)(w + WS_Q); bf16* ATT = (bf16*)(w + WS_ATT);
                const float* ksm = out + O_KS + (size_t)l * MS * DHALF; const float* vsm = out + O_VS + (size_t)l * MS * DHALF;
                const int row0 = MP + b * TSM;
                const size_t cb = ((size_t)(l * NB + b) * PAST) * DHALF + wave * HD;
                attn_tile<true>(wl, lane, PAST, (PAST + 30) >> 5, QB + (size_t)row0 * DHALF + wave * HD, nullptr, nullptr, INP(I_CK) + cb, INP(I_CV) + cb,
                                ksm + (size_t)(b * TSM) * DHALF + wave * HD, vsm + (size_t)(b * TSM) * DHALF + wave * HD, ATT + (size_t)row0 * DHALF + wave * HD);
            }
#endif
        }
#endif
        xcd_barrier(bar);
#ifndef SKIP_P3
        for (int rep = 0; rep < REP_P3; ++rep)
        {
            WSL(w);
            pg8::Gemm g{(const bf16*)(w + WS_YPRE), (const bf16*)(w + WS_WGLU) + (size_t)l * DHALF * DHALF, MT, DHALF, DHALF}; pg8::StaticOrder S; S.init(MT, DHALF, G, bid);
            EpiGlu E{ws, INP(I_BGLU) + (size_t)l * DHALF};
            pg8::gemm_phase<EpiGlu, pg8::StaticOrder, true, true>(lds, g, S, E);
        }
#endif
        xcd_barrier(bar);
#ifndef SKIP_P4
        for (int rep = 0; rep < REP_P4; ++rep)
        {
            WSL(w); LNL;
            const bf16* ATT = (const bf16*)(w + WS_ATT); const bf16* SSMY = (const bf16*)(w + WS_SSMY); const bf16* GA = (const bf16*)(w + WS_GA); const bf16* GS = (const bf16*)(w + WS_GS); bf16* CAT = (bf16*)(w + WS_CAT);
            const float* gat = INP(I_GATT) + (size_t)l * DHALF; const float* gss = INP(I_GSSM) + (size_t)l * DHALF;
            const f32x4 ga0 = *(const f32x4*)(gat + lane * 8), ga1 = *(const f32x4*)(gat + lane * 8 + 4), gs0 = *(const f32x4*)(gss + lane * 8), gs1 = *(const f32x4*)(gss + lane * 8 + 4);
            for (int row = gw; row < MT; row += NGW) {
                const size_t o = (size_t)row * DHALF + lane * 8;
                const v4u aw = *(const v4u*)(ATT + o), sw = *(const v4u*)(SSMY + o), gaw = *(const v4u*)(GA + o), gsw = *(const v4u*)(GS + o);
                float av[8], sv[8], gav[8], gsv[8]; float qa = 0.f, qs = 0.f;
#pragma unroll
                for (int e = 0; e < 4; ++e) {
                    av[2 * e] = __builtin_bit_cast(float, aw[e] << 16); av[2 * e + 1] = __builtin_bit_cast(float, aw[e] & 0xffff0000u);
                    sv[2 * e] = __builtin_bit_cast(float, sw[e] << 16); sv[2 * e + 1] = __builtin_bit_cast(float, sw[e] & 0xffff0000u);
                    gav[2 * e] = __builtin_bit_cast(float, gaw[e] << 16); gav[2 * e + 1] = __builtin_bit_cast(float, gaw[e] & 0xffff0000u);
                    gsv[2 * e] = __builtin_bit_cast(float, gsw[e] << 16); gsv[2 * e + 1] = __builtin_bit_cast(float, gsw[e] & 0xffff0000u);
                }
#pragma unroll
                for (int e = 0; e < 8; ++e) { qa += av[e] * av[e]; qs += sv[e] * sv[e]; }
                qa = wave_sum(qa); qs = wave_sum(qs);
                const float ra = 1.0f / sqrtf(qa * (1.0f / DHALF) + EPS), rsn = 1.0f / sqrtf(qs * (1.0f / DHALF) + EPS);
                f32x4 o0, o1, o2, o3;
#pragma unroll
                for (int e = 0; e < 4; ++e) { o0[e] = av[e] * ra * ga0[e] * gav[e]; o1[e] = av[4 + e] * ra * ga1[e] * gav[4 + e]; o2[e] = sv[e] * rsn * gs0[e] * gsv[e]; o3[e] = sv[4 + e] * rsn * gs1[e] * gsv[4 + e]; }
                *(v4u*)(CAT + (size_t)row * DM + lane * 8) = __builtin_bit_cast(v4u, pack8(o0, o1));
                *(v4u*)(CAT + (size_t)row * DM + DHALF + lane * 8) = __builtin_bit_cast(v4u, pack8(o2, o3));
            }
        }
#endif
        xcd_barrier(bar);
#ifndef SKIP_P5
        {
            WSL(w);
            pg8::Gemm g{(const bf16*)(w + WS_CAT), (const bf16*)(w + WS_WOUT) + (size_t)l * DM * DM, MT, DM, DM}; pg8::StaticOrder S; S.init(MT, DM, G, bid);
            EpiOut E{ws, l};
            pg8::gemm_phase<EpiOut, pg8::StaticOrder, true, true>(lds, g, S, E);
        }
#endif
        xcd_barrier(bar);
    }
    {
        WSL(w); LNL;
        const float* X = (const float*)(w + WS_X);
        const float* fg = INP(I_FG); const float* ssf = (const float*)(w + WS_SS) + (size_t)NL * MT;
        f32x4 gv[4];
#pragma unroll
        for (int j = 0; j < 4; ++j) gv[j] = *(const f32x4*)(fg + j * 256 + lane * 4);
        for (int row = gw; row < MT; row += NGW) {
            const float rs = 1.0f / sqrtf(ssf[row] * (1.0f / DM) + EPS);
            const float* xr = X + (size_t)row * DM; float* yo = (row < MP) ? out + O_YP + (size_t)row * DM : out + O_YS + (size_t)(row - MP) * DM;
#pragma unroll
            for (int j = 0; j < 4; ++j) { const f32x4 v = *(const f32x4*)(xr + j * 256 + lane * 4); *(f32x4*)(yo + j * 256 + lane * 4) = v * rs * gv[j]; }
        }
    }
}

extern "C" void kernel_launch(void* const* d_in, const int* in_sizes, int n_in, void* d_out, int out_size, void* d_ws, size_t ws_size, hipStream_t stream) {
    static int grid = 0;
    if (grid == 0) {
        if (n_in != 22 || in_sizes[0] != MP * DM || (size_t)out_size != O_END || ws_size < WS_END) {
            fprintf(stderr, "kernel_launch: unexpected shapes: n_in %d in0 %d out %d ws %zu (need %zu); nothing launched\n", n_in, n_in > 0 ? in_sizes[0] : -1, out_size, ws_size, (size_t)WS_END); grid = -1; return; }
        int dev = 0, cus = 0, per_cu = 0;
        if (hipGetDevice(&dev) != hipSuccess || hipDeviceGetAttribute(&cus, hipDeviceAttributeMultiprocessorCount, dev) != hipSuccess) { grid = -1; return; }
        if (hipFuncSetAttribute((const void*)hymba_fwd, hipFuncAttributeMaxDynamicSharedMemorySize, LDS_BYTES) != hipSuccess) { fprintf(stderr, "kernel_launch: hipFuncSetAttribute failed\n"); grid = -1; return; }
        if (hipOccupancyMaxActiveBlocksPerMultiprocessor(&per_cu, (const void*)hymba_fwd, NWAVES * 64, LDS_BYTES) != hipSuccess || per_cu < 1)
            fprintf(stderr, "kernel_launch: note: occupancy query reports %d workgroups per CU\n", per_cu);
        (void)hipGetLastError();
        grid = cus;
    }
    if (grid < 0) return;
    if (hipMemsetAsync((char*)d_ws + WS_CTL, 0, CTL_ZERO_BYTES, stream) != hipSuccess) { fprintf(stderr, "kernel_launch: memset failed\n"); return; }
    Args a{};
    for (int i = 0; i < 22; ++i) a.in[i] = (const float*)d_in[i];
    a.out = (float*)d_out; a.ws = (unsigned char*)d_ws;
    hipLaunchKernelGGL(hymba_fwd, dim3(grid), dim3(NWAVES * 64), LDS_BYTES, stream, a);
    const hipError_t le = hipPeekAtLastError();
    if (le != hipSuccess) fprintf(stderr, "kernel_launch: launch failed: %s\n", hipGetErrorName(le));
}
```

```cpp
#include <hip/hip_runtime.h>
#include <hip/hip_bf16.h>
#include <cstdio>
#include <cstdint>
#include <cmath>
namespace pg8 {
#define PG8_LAS __attribute__((address_space(3)))
typedef unsigned short bf16_t;
typedef short bf16x8 __attribute__((ext_vector_type(8)));
typedef float f32x4 __attribute__((ext_vector_type(4)));
typedef unsigned u32x4 __attribute__((ext_vector_type(4)));
constexpr int BM = 256, BK = 64, HALF = 128, HTB = HALF * BK * 2  , STAGE_BYTES = 8 * HTB, NXCD = 8, WGM = 8;

__host__ __device__ __forceinline__ int lds_byte(int r, int c) { const int st = (r >> 4) * 2 + (c >> 5), rr = r & 15, cc = c & 31, ob = rr * 64 + cc * 2; return st * 1024 + (ob ^ (((ob >> 9) & 1) << 5)); }
__host__ __device__ __forceinline__ void stage_rc(int b, int& R, int& C) { const int st = b / 1024, sb = b % 1024, swz = sb ^ (((sb >> 9) & 1) << 5); R = (st >> 1) * 16 + swz / 64; C = (st & 1) * 32 + (swz % 64) / 2; }
__host__ __device__ __forceinline__ int perm32(int rho) { const int n = rho >> 4, i = rho & 15; return 8 * (i >> 2) + 4 * n + (i & 3); }

struct Unit { int pm, pn; };
struct Gemm { const bf16_t* A; const bf16_t* Bt; int M, N, K; };

struct StaticOrder {
    int nM, nN, nwg, G, c;
    __host__ __device__ void init(int M, int N, int G_, int c_) { nM = M / BM; nN = N / BM; nwg = nM * nN; G = G_; c = c_; }
    __host__ __device__ bool next(int i, Unit& u) const {
        const long L = (long)i * G + c; if (L >= nwg) return false;
        int wgid = (int)L; { const int q = nwg / NXCD, r = nwg % NXCD, xcd = wgid % NXCD, off = wgid / NXCD; wgid = (xcd < r ? xcd * (q + 1) : r * (q + 1) + (xcd - r) * q) + off; }
        const int nig = WGM * nN, gid = wgid / nig, fm = gid * WGM, gsz = (nM - fm) < WGM ? (nM - fm) : WGM;
        u.pm = fm + ((wgid % nig) % gsz); u.pn = (wgid % nig) / gsz; return true;
    }
    __device__ __forceinline__ void a_ready(const Unit&) const {}
    __device__ __forceinline__ void done(const Unit&) const {}
};

__device__ __forceinline__ unsigned cvt_pk_bf16(float lo, float hi) { unsigned r; asm volatile("v_cvt_pk_bf16_f32 %0, %1, %2" : "=v"(r) : "v"(lo), "v"(hi)); return r; }
typedef float f32x2 __attribute__((ext_vector_type(2)));
template <class Epi, class Sched, bool ALIGN_EPI = false, bool SP2 = false>
__device__ __forceinline__ void gemm_phase(PG8_LAS unsigned char* lds, const Gemm g, const Sched& S, const Epi& E) {
    int tid_ = threadIdx.x; asm volatile("" : "+v"(tid_));
    const int tid = tid_, wid = __builtin_amdgcn_readfirstlane(tid >> 6), lane = tid & 63, wr = wid >> 2, wc = wid & 3, fr = lane & 15, fq = lane >> 4;
    const int K = g.K, nt = K / BK;
    unsigned voffA[2], voffB[2];
#pragma unroll
    for (int i = 0; i < 2; ++i) { int R, C; stage_rc(tid * 16 + i * 8192, R, C); const int Rb = Epi::PERM ? ((R & ~31) + perm32(R & 31)) : R;
        voffA[i] = (unsigned)(R * K + C) * 2u; voffB[i] = (unsigned)(Rb * K + C) * 2u; }
    const size_t kstep = (size_t)(BK * 2);
    const size_t hstep = (size_t)HALF * K * 2;
    const size_t tstep = 2 * hstep;
    const unsigned ldsw = (unsigned)wid * 1024u;
    const int aoff = lds_byte(wr * 64 + fr, fq * 8), boff = lds_byte(wc * 32 + fr, fq * 8);
#define PG8_SA(b, h) (((b) * 2 + (h)) * HTB)
#define PG8_SB(b, h) ((4 + (b) * 2 + (h)) * HTB)
#define PG8_STAGE(bufoff, gbase, voff) do { _Pragma("unroll") for (int _i = 0; _i < 2; ++_i) \
        __builtin_amdgcn_global_load_lds((const unsigned*)((const char*)(gbase) + (voff)[_i]), (PG8_LAS unsigned*)(lds + (bufoff) + ldsw + _i * 8192), 16, 0, 0); } while (0)
#define PG8_LDA(dst, b, h) do { _Pragma("unroll") for (int m = 0; m < 4; ++m) _Pragma("unroll") for (int k = 0; k < 2; ++k) dst[m][k] = *(const PG8_LAS bf16x8*)(lds + PG8_SA(b, h) + aoff + m * 2048 + k * 1024); } while (0)
#define PG8_LDB(dst, b, h) do { _Pragma("unroll") for (int n = 0; n < 2; ++n) _Pragma("unroll") for (int k = 0; k < 2; ++k) dst[n][k] = *(const PG8_LAS bf16x8*)(lds + PG8_SB(b, h) + boff + n * 2048 + k * 1024); } while (0)
#define PG8_MMA(ai, bj, At, Bt) do { __builtin_amdgcn_s_setprio(1); _Pragma("unroll") for (int m = 0; m < 4; ++m) _Pragma("unroll") for (int n = 0; n < 2; ++n) _Pragma("unroll") for (int k = 0; k < 2; ++k) \
        acc[ai][bj][m][n] = __builtin_amdgcn_mfma_f32_16x16x32_bf16(Bt[n][k], At[m][k], acc[ai][bj][m][n], 0, 0, 0); __builtin_amdgcn_s_setprio(0); } while (0)
#define PG8_WAIT_V(n) asm volatile("s_waitcnt vmcnt(" #n ")" ::: "memory")
#define PG8_WAIT_L(n) asm volatile("s_waitcnt lgkmcnt(" #n ")" ::: "memory")
#define PG8_BAR __builtin_amdgcn_s_barrier()
#define PG8_SCHED __builtin_amdgcn_sched_barrier(0)
    Unit cur, nxt; int ui = 0;
    if (!S.next(0, cur)) return;
    f32x4 acc[2][2][4][2];
#pragma unroll
    for (int a = 0; a < 2; ++a)
#pragma unroll
        for (int b = 0; b < 2; ++b)
#pragma unroll
            for (int m = 0; m < 4; ++m)
#pragma unroll
                for (int n = 0; n < 2; ++n) acc[a][b][m][n] = (f32x4){0.f, 0.f, 0.f, 0.f};
    bf16x8 At[4][2], B0[2][2], B1[2][2];
    const char* cA = (const char*)g.A + (size_t)cur.pm * tstep; const char* cB = (const char*)g.Bt + (size_t)cur.pn * tstep;
    S.a_ready(cur);
    if constexpr (Epi::MIDK) E.prep(lds, cur, 0, tid);
    if constexpr (SP2) {
        PG8_STAGE(PG8_SB(0, 0), cB, voffB); PG8_STAGE(PG8_SB(0, 1), cB + hstep, voffB); PG8_STAGE(PG8_SA(0, 0), cA, voffA); PG8_STAGE(PG8_SA(0, 1), cA + hstep, voffA);
        if (wr == 1) PG8_BAR;
        PG8_WAIT_V(2); PG8_BAR;
        PG8_STAGE(PG8_SB(1, 0), cB + kstep, voffB); PG8_STAGE(PG8_SA(1, 0), cA + kstep, voffA); PG8_STAGE(PG8_SB(1, 1), cB + hstep + kstep, voffB);
        PG8_WAIT_V(6); PG8_BAR;
    } else {
        PG8_STAGE(PG8_SB(0, 0), cB, voffB); PG8_STAGE(PG8_SA(0, 0), cA, voffA); PG8_STAGE(PG8_SB(0, 1), cB + hstep, voffB); PG8_STAGE(PG8_SA(0, 1), cA + hstep, voffA);
        if (wr == 1) PG8_BAR;
        PG8_WAIT_V(4); PG8_BAR;
        PG8_STAGE(PG8_SB(1, 0), cB + kstep, voffB); PG8_STAGE(PG8_SA(1, 0), cA + kstep, voffA); PG8_STAGE(PG8_SB(1, 1), cB + hstep + kstep, voffB);
        PG8_WAIT_V(6); PG8_BAR;
    }
    for (;;) {
        const bool has_next = S.next(ui + 1, nxt);
        const char* nA = has_next ? (const char*)g.A + (size_t)nxt.pm * tstep : cA; const char* nB = has_next ? (const char*)g.Bt + (size_t)nxt.pn * tstep : cB;
        for (int t = 0; t < nt; t += 2) {
            if constexpr (Epi::MIDK) { if (t == (nt >> 1)) E.midk(acc, lds, ui, wr, fr); }
            const bool last = (t == nt - 2);
            const char* a1 = cA + (size_t)(t + 1) * kstep;
            const char* a2 = last ? nA : cA + (size_t)(t + 2) * kstep; const char* b2 = last ? nB : cB + (size_t)(t + 2) * kstep;
            const char* a3 = a2 + kstep; const char* b3 = b2 + kstep;
            if (last && has_next) S.a_ready(nxt);
            if constexpr (SP2) {
            PG8_LDB(B0, 0, 0); PG8_LDB(B1, 0, 1); PG8_SCHED; PG8_LDA(At, 0, 0); PG8_STAGE(PG8_SA(1, 1), a1 + hstep, voffA);
            PG8_WAIT_V(8); PG8_WAIT_L(0); PG8_BAR; PG8_MMA(0, 0, At, B0); PG8_MMA(0, 1, At, B1); PG8_BAR; PG8_SCHED;
            PG8_LDA(At, 0, 1); PG8_STAGE(PG8_SB(0, 0), b2, voffB); PG8_STAGE(PG8_SB(0, 1), b2 + hstep, voffB); PG8_STAGE(PG8_SA(0, 0), a2, voffA);
            PG8_WAIT_V(8); PG8_WAIT_L(0); PG8_BAR; PG8_MMA(1, 0, At, B0); PG8_MMA(1, 1, At, B1); PG8_BAR; PG8_SCHED;
            PG8_LDB(B0, 1, 0); PG8_LDB(B1, 1, 1); PG8_SCHED; PG8_LDA(At, 1, 0); PG8_STAGE(PG8_SA(0, 1), a2 + hstep, voffA);
            PG8_WAIT_V(8); PG8_WAIT_L(0); PG8_BAR; PG8_MMA(0, 0, At, B0); PG8_MMA(0, 1, At, B1); PG8_BAR; PG8_SCHED;
            PG8_LDA(At, 1, 1); PG8_STAGE(PG8_SB(1, 0), b3, voffB); PG8_STAGE(PG8_SB(1, 1), b3 + hstep, voffB); PG8_STAGE(PG8_SA(1, 0), a3, voffA);
            PG8_WAIT_V(8); PG8_WAIT_L(0); PG8_BAR; PG8_MMA(1, 0, At, B0); PG8_MMA(1, 1, At, B1); PG8_BAR; PG8_SCHED;
            } else {
            PG8_LDB(B0, 0, 0); PG8_SCHED; PG8_LDA(At, 0, 0); PG8_STAGE(PG8_SA(1, 1), a1 + hstep, voffA);
            PG8_WAIT_L(8); PG8_BAR; PG8_WAIT_L(0); PG8_MMA(0, 0, At, B0); PG8_BAR; PG8_SCHED;
            PG8_LDB(B1, 0, 1); PG8_STAGE(PG8_SB(0, 0), b2, voffB);
            PG8_BAR; PG8_WAIT_L(0); PG8_MMA(0, 1, At, B1); PG8_BAR;
            PG8_LDA(At, 0, 1); PG8_STAGE(PG8_SA(0, 0), a2, voffA);
            PG8_BAR; PG8_WAIT_L(0); PG8_MMA(1, 0, At, B0); PG8_BAR; PG8_SCHED;
            PG8_STAGE(PG8_SB(0, 1), b2 + hstep, voffB);
            PG8_WAIT_V(6); PG8_BAR; PG8_MMA(1, 1, At, B1); PG8_BAR;
            PG8_LDB(B0, 1, 0); PG8_SCHED; PG8_LDA(At, 1, 0); PG8_STAGE(PG8_SA(0, 1), a2 + hstep, voffA);
            PG8_WAIT_L(8); PG8_BAR; PG8_WAIT_L(0); PG8_MMA(0, 0, At, B0); PG8_BAR; PG8_SCHED;
            PG8_LDB(B1, 1, 1); PG8_STAGE(PG8_SB(1, 0), b3, voffB);
            PG8_BAR; PG8_WAIT_L(0); PG8_MMA(0, 1, At, B1); PG8_BAR;
            PG8_LDA(At, 1, 1); PG8_STAGE(PG8_SA(1, 0), a3, voffA);
            PG8_BAR; PG8_WAIT_L(0); PG8_MMA(1, 0, At, B0); PG8_BAR; PG8_SCHED;
            PG8_STAGE(PG8_SB(1, 1), b3 + hstep, voffB);
            PG8_WAIT_V(6); PG8_BAR; PG8_MMA(1, 1, At, B1); PG8_BAR;
            }
        }
        if constexpr (ALIGN_EPI) { if (wr == 0) PG8_BAR; }
        if constexpr (Epi::MIDK) { E.epi(acc, cur, wr, wc, fr, fq, lds, ui, has_next, nxt, tid); S.done(cur); }
        else if constexpr (!Epi::AFTER_DRAIN) { E(acc, cur, wr, wc, fr, fq); S.done(cur); }
        if (!has_next) break;
#pragma unroll
        for (int a = 0; a < 2; ++a)
#pragma unroll
            for (int b = 0; b < 2; ++b)
#pragma unroll
                for (int m = 0; m < 4; ++m)
#pragma unroll
                    for (int n = 0; n < 2; ++n) acc[a][b][m][n] = (f32x4){0.f, 0.f, 0.f, 0.f};
        cur = nxt; cA = nA; cB = nB; ++ui;
        if constexpr (ALIGN_EPI) { if (wr == 1) PG8_BAR; }
    }
    PG8_WAIT_V(0);
    if constexpr (!ALIGN_EPI) { if (wr == 0) PG8_BAR; }
    PG8_BAR;
    if constexpr (Epi::AFTER_DRAIN) { E.fused(acc, cur, wr, wc, fr, fq, lds, wid, lane); S.done(cur); }
#undef PG8_SA
#undef PG8_SB
#undef PG8_STAGE
#undef PG8_LDA
#undef PG8_LDB
#undef PG8_MMA
#undef PG8_WAIT_V
#undef PG8_WAIT_L
#undef PG8_BAR
#undef PG8_SCHED
}
}
#define GAS __attribute__((address_space(1)))
#define LAS __attribute__((address_space(3)))
typedef unsigned short bf16;
typedef unsigned v4u __attribute__((ext_vector_type(4)));
typedef float f32x4 __attribute__((ext_vector_type(4)));
typedef short bf16x8 __attribute__((ext_vector_type(8)));
typedef GAS unsigned gu32;
typedef GAS unsigned long long gu64;
#define RLX_AGENT __ATOMIC_RELAXED, __HIP_MEMORY_SCOPE_AGENT
#define LDS_WAIT() asm volatile("s_waitcnt lgkmcnt(0)" ::: "memory")
#define VM_WAIT() asm volatile("s_waitcnt vmcnt(0)" ::: "memory")
__device__ __forceinline__ unsigned long long rt() { return __builtin_amdgcn_s_memrealtime(); }
__device__ __forceinline__ unsigned f2bf(float f) { unsigned u = __builtin_bit_cast(unsigned, f); return (u + 0x7fffu + ((u >> 16) & 1u)) >> 16; }
__device__ __forceinline__ unsigned pk2(float lo, float hi) { return f2bf(lo) | (f2bf(hi) << 16); }

#define XB_TMO      128
#define XB_XCNT(j)  (256  + 64 * (j))
#define XB_XSUB(j)  (1280 + 64 * (j))
#define XB_XGEN(j)  (2304 + 64 * (j))
#define XB_TOP      3328
#define XB_TOPGEN   3392
#define XCD_BAR_WORDS 3456
#define XB_SPIN_CAP (1u << 18)

__device__ __forceinline__ unsigned xb_ld(unsigned* p)              { return __hip_atomic_load(p, __ATOMIC_RELAXED, __HIP_MEMORY_SCOPE_AGENT); }
__device__ __forceinline__ unsigned xb_add(unsigned* p, unsigned v) { return __hip_atomic_fetch_add(p, v, __ATOMIC_RELAXED, __HIP_MEMORY_SCOPE_AGENT); }
__device__ __forceinline__ unsigned xb_xcc_id() { return (unsigned)__builtin_amdgcn_s_getreg((3 << 11) | 20) & 0xFu; }
#define XB_SPIN(cond, bar) do { unsigned _sp = 0; while (cond) { __builtin_amdgcn_s_sleep(1); \
    if ((++_sp & 255u) == 0u) { if (xb_ld(&(bar)[XB_TMO])) break; if (_sp > XB_SPIN_CAP) { atomicAdd(&(bar)[XB_TMO], 1u); break; } } } } while (0)

struct XcdBarrier {
    unsigned* bar; unsigned x;
    volatile LAS unsigned* st;
};

__device__ __forceinline__ XcdBarrier xcd_barrier_post(unsigned* bar, volatile LAS unsigned* st) {
    XcdBarrier b; b.bar = bar; b.x = xb_xcc_id(); b.st = st;
    if (threadIdx.x == 0) (void)xb_add(&bar[XB_XCNT(b.x)], 1u);
    return b;
}
__device__ __forceinline__ void xcd_barrier_complete(unsigned* bar, unsigned x, unsigned& nloc, unsigned& nx) {
    const unsigned G = gridDim.x * gridDim.y * gridDim.z;
    unsigned sum, cnt, mine, sp = 0u;
    for (;;) {
        sum = 0u; cnt = 0u; mine = 0u;
#pragma unroll
        for (unsigned j = 0; j < 16; ++j) { const unsigned c = xb_ld(&bar[XB_XCNT(j)]); sum += c; cnt += (c > 0u) ? 1u : 0u; mine = (j == x) ? c : mine; }
        if (sum == G) break;
        __builtin_amdgcn_s_sleep(1);
        if ((++sp & 255u) == 0u) { if (xb_ld(&bar[XB_TMO])) break; if (sp > XB_SPIN_CAP) { atomicAdd(&bar[XB_TMO], 1u); break; } }
    }
    nloc = mine > 0u ? mine : 1u; nx = cnt > 0u ? cnt : 1u;
}

__device__ __forceinline__ void xcd_barrier(const XcdBarrier& b) {
    asm volatile("s_waitcnt vmcnt(0)" ::: "memory");
    __syncthreads();
    if (threadIdx.x == 0) {
        unsigned* bar = b.bar;
        __builtin_amdgcn_s_waitcnt(0);
        unsigned nloc = b.st[0], nx = b.st[1];
        if (nloc == 0u) { xcd_barrier_complete(bar, b.x, nloc, nx); b.st[0] = nloc; b.st[1] = nx; }
        const unsigned old = xb_add(&bar[XB_XSUB(b.x)], 1u);
        const unsigned gen = old / nloc;
        if (old + 1u == (gen + 1u) * nloc) {
            __builtin_amdgcn_fence(__ATOMIC_RELEASE, "agent");
            asm volatile("s_waitcnt vmcnt(0)" ::: "memory");
            const unsigned og = xb_add(&bar[XB_TOP], 1u);
            const unsigned tg = og / nx;
            if (og + 1u == (tg + 1u) * nx) xb_add(&bar[XB_TOPGEN], 1u);
            else XB_SPIN(xb_ld(&bar[XB_TOPGEN]) == tg, bar);
            __builtin_amdgcn_fence(__ATOMIC_ACQUIRE, "agent");
            xb_add(&bar[XB_XGEN(b.x)], 1u);
            asm volatile("s_waitcnt vmcnt(0)" ::: "memory");
        } else {
            XB_SPIN(xb_ld(&bar[XB_XGEN(b.x)]) == gen, bar);
            __builtin_amdgcn_fence(__ATOMIC_ACQUIRE, "agent");
            asm volatile("s_waitcnt vmcnt(0)" ::: "memory");
        }
    }
    __syncthreads();
}
constexpr int NWAVES = 8;
constexpr int DM = 1024, DHALF = 512, DIN = 3072;
constexpr int NL = 4, NB = 16, TP = 4096, TSM = 32, PAST = 4096, NH = 8, HD = 64, NG = 32, NP = 64, NC = 16;
constexpr int MP = NB * TP, MS = NB * TSM, MT = MP + MS;
constexpr float EPS = 1e-6f;
constexpr float LOG2E = 1.4426950408889634f;
constexpr float QSCALE = 0.125f * LOG2E;
constexpr float EXIT_THR = 7.5e-37f;

constexpr size_t O_YP = 0, O_YS = O_YP + (size_t)MP * DM, O_KP = O_YS + (size_t)MS * DM, O_VP = O_KP + (size_t)NL * MP * DHALF, O_RP = O_VP + (size_t)NL * MP * DHALF,
                 O_IP = O_RP + (size_t)NL * NB * NG * NP, O_KS = O_IP + (size_t)NL * NB * NG * NP, O_VS = O_KS + (size_t)NL * MS * DHALF, O_RS = O_VS + (size_t)NL * MS * DHALF,
                 O_IS = O_RS + (size_t)NL * NB * NG * NP, O_END = O_IS + (size_t)NL * NB * NG * NP;

constexpr size_t MiB = 1u << 20;
constexpr size_t WS_CTL = 0;
constexpr size_t WS_SS = 1 * MiB, WS_SSS = 3 * MiB, CTL_ZERO_BYTES = 5 * MiB;
constexpr size_t WS_SSA = 5 * MiB;
constexpr size_t WS_PAR = 7 * MiB;
constexpr size_t WS_ABAR = WS_PAR, WS_BBF = WS_PAR + 64 * 1024, WS_CBF = WS_BBF + 512 * 1024;
constexpr size_t WS_WIN = 9 * MiB;
constexpr size_t WS_WOUT = 33 * MiB;
constexpr size_t WS_WGLU = 41 * MiB;
constexpr size_t WS_X = 44 * MiB;
constexpr size_t WS_XB = WS_X + 258 * MiB;
constexpr size_t WS_Q = WS_XB + 129 * MiB;
constexpr size_t WS_KT = WS_Q + 65 * MiB;
constexpr size_t WS_VT = WS_KT + 64 * MiB;
constexpr size_t WS_GA = WS_VT + 64 * MiB;
constexpr size_t WS_U = WS_GA + 65 * MiB;
constexpr size_t WS_GS = WS_U + 65 * MiB;
constexpr size_t WS_YPRE = WS_GS + 65 * MiB;
constexpr size_t WS_CAT = WS_YPRE + 65 * MiB;
constexpr size_t WS_END = WS_CAT + 129 * MiB;
constexpr int CW_BAR = 4096;

constexpr int RING_BYTES = 131072;
constexpr int ENDS_OFF = 65536;
constexpr int LDSCTL_OFF = RING_BYTES, MISC_OFF = LDSCTL_OFF + 320;
constexpr int TAB_OFF = LDSCTL_OFF + 2048;
constexpr int LDS_BYTES = 147456;

typedef float f32x2 __attribute__((ext_vector_type(2)));
typedef float f32x16 __attribute__((ext_vector_type(16)));
typedef __bf16 bf16x2_t __attribute__((ext_vector_type(2)));
typedef short s16x4 __attribute__((ext_vector_type(4)));
__device__ __forceinline__ unsigned cvtpk(float lo, float hi) { f32x2 v = {lo, hi}; bf16x2_t b = __builtin_convertvector(v, bf16x2_t); return __builtin_bit_cast(unsigned, b); }
__device__ __forceinline__ bf16x8 pack8(f32x4 a, f32x4 b) { v4u w; w.x = cvtpk(a[0], a[1]); w.y = cvtpk(a[2], a[3]); w.z = cvtpk(b[0], b[1]); w.w = cvtpk(b[2], b[3]); return __builtin_bit_cast(bf16x8, w); }
__device__ __forceinline__ float bf2f(unsigned short b) { return __builtin_bit_cast(float, (unsigned)b << 16); }
__device__ __forceinline__ float ex2(float x) { return __builtin_amdgcn_exp2f(x); }
__device__ __forceinline__ float rcp(float x) { return __builtin_amdgcn_rcpf(x); }
__device__ __forceinline__ float silu_f(float v) { return v * rcp(1.f + ex2(-LOG2E * v)); }
__device__ __forceinline__ float sigm_f(float v) { return rcp(1.f + ex2(-LOG2E * v)); }
__device__ __forceinline__ float gelu_tanh_f(float y) {
    const float a2 = y * (1.5957691216f + 0.0713548163f * y * y);
    return y * rcp(1.f + ex2(-LOG2E * a2));
}
__device__ __forceinline__ float wave_sum(float v) {
#pragma unroll
    for (int o = 1; o < 64; o <<= 1) v += __shfl_xor(v, o);
    return v;
}
typedef short v4i16_t __attribute__((ext_vector_type(4)));
__device__ __forceinline__ s16x4 vtr(const LAS unsigned char* p) { return __builtin_bit_cast(s16x4, __builtin_amdgcn_ds_read_tr16_b64_v4i16((LAS v4i16_t*)p)); }
#define MFMA32(a, b, c) __builtin_amdgcn_mfma_f32_32x32x16_bf16((a), (b), (c), 0, 0, 0)
#define MFMA16(a, b, c) __builtin_amdgcn_mfma_f32_16x16x32_bf16((a), (b), (c), 0, 0, 0)

struct EpiProj {
    static constexpr bool PERM = true, AFTER_DRAIN = false, MIDK = false;
    unsigned char* ws_; float* out_; int l;
    __device__ __forceinline__ void operator()(const pg8::f32x4 (&acc)[2][2][4][2], const pg8::Unit& u, int wr, int wc, int fr, int fq) const {
        GAS unsigned char* wg_ = (GAS unsigned char*)ws_; GAS float* og_ = (GAS float*)out_; asm volatile("" : "+s"(wg_), "+s"(og_)); unsigned char* const w = (unsigned char*)wg_; float* const o = (float*)og_;
        const float* ss = (const float*)(w + WS_SS) + (size_t)l * MT;
        bf16* Q = (bf16*)(w + WS_Q); unsigned char* KT = w + WS_KT; unsigned char* VT = w + WS_VT; bf16* GA = (bf16*)(w + WS_GA); bf16* U = (bf16*)(w + WS_U); bf16* GS = (bf16*)(w + WS_GS);
        float* kp = o + O_KP + (size_t)l * MP * DHALF; float* vp = o + O_VP + (size_t)l * MP * DHALF; float* ks = o + O_KS + (size_t)l * MS * DHALF; float* vs = o + O_VS + (size_t)l * MS * DHALF;
        const int typ = u.pn >> 1;
        const int csb = (u.pn & 1) * 256 + wc * 32 + 8 * fq;
        const int rowb = u.pm * 256 + wr * 64 + fr;
        float rs[2][4];
#pragma unroll
        for (int ai = 0; ai < 2; ++ai)
#pragma unroll
            for (int m = 0; m < 4; ++m) rs[ai][m] = ss[rowb + ai * 128 + m * 16];
#pragma unroll
        for (int ai = 0; ai < 2; ++ai)
#pragma unroll
            for (int m = 0; m < 4; ++m) rs[ai][m] = 1.0f / sqrtf(rs[ai][m] * (1.0f / DM) + EPS);
        if (typ == 0) {
#pragma unroll
            for (int ai = 0; ai < 2; ++ai)
#pragma unroll
                for (int m = 0; m < 4; ++m) { const int row = rowb + ai * 128 + m * 16; const float s = rs[ai][m] * QSCALE;
#pragma unroll
                    for (int bj = 0; bj < 2; ++bj) { const int cs = csb + bj * 128;
                        *(v4u*)(Q + (size_t)row * DHALF + cs) = __builtin_bit_cast(v4u, pack8(acc[ai][bj][m][0] * s, acc[ai][bj][m][1] * s)); } }
        } else if (typ == 1 || typ == 2) {
            const bool isk = (typ == 1); const bool prompt = (u.pm < MP / 256);
            float* of = prompt ? (isk ? kp : vp) : (isk ? ks : vs);
            unsigned char* tb = isk ? KT : VT;
#pragma unroll
            for (int ai = 0; ai < 2; ++ai)
#pragma unroll
                for (int m = 0; m < 4; ++m) { const int row = rowb + ai * 128 + m * 16; const float s = rs[ai][m];
                    const int orow = prompt ? row : row - MP;
#pragma unroll
                    for (int bj = 0; bj < 2; ++bj) { const int cs = csb + bj * 128;
                        const f32x4 v0 = acc[ai][bj][m][0] * s, v1 = acc[ai][bj][m][1] * s;
                        float* op = of + (size_t)orow * DHALF + cs; *(f32x4*)op = v0; *(f32x4*)(op + 4) = v1;
                        if (prompt) { const int b = row >> 12, t = row & 4095, hd = cs >> 6, ch = (cs & 63) >> 3;
                            const size_t tile = ((size_t)(b * NH + hd) * 64 + (t >> 6)) * 8192;
                            const size_t off = isk ? tile + ch * 1024 + (t & 63) * 16 : tile + (ch >> 2) * 4096 + (t & 63) * 64 + (ch & 3) * 16;
                            *(v4u*)(tb + off) = __builtin_bit_cast(v4u, pack8(v0, v1)); } } }
        } else {
            bf16* ob = (typ == 3) ? GA : (typ == 4) ? U : GS; const bool act = (typ != 4);
#pragma unroll
            for (int ai = 0; ai < 2; ++ai)
#pragma unroll
                for (int m = 0; m < 4; ++m) { const int row = rowb + ai * 128 + m * 16; const float s = rs[ai][m];
#pragma unroll
                    for (int bj = 0; bj < 2; ++bj) { const int cs = csb + bj * 128;
                        f32x4 v0 = acc[ai][bj][m][0] * s, v1 = acc[ai][bj][m][1] * s;
                        if (act) {
#pragma unroll
                            for (int e = 0; e < 4; ++e) { v0[e] = silu_f(v0[e]); v1[e] = silu_f(v1[e]); } }
                        const size_t off = act ? (size_t)row * DHALF + cs : ((size_t)(cs >> 4) * MT + row) * NC + (cs & 8);
                        *(v4u*)(ob + off) = __builtin_bit_cast(v4u, pack8(v0, v1)); } }
        }
    }
};
struct EpiGlu {
    static constexpr bool PERM = true, AFTER_DRAIN = false, MIDK = false;
    unsigned char* ws_; const float* bias; int l;
    __device__ __forceinline__ void operator()(const pg8::f32x4 (&acc)[2][2][4][2], const pg8::Unit& u, int wr, int wc, int fr, int fq) const {
        GAS unsigned char* wg_ = (GAS unsigned char*)ws_; asm volatile("" : "+s"(wg_)); unsigned char* const w = (unsigned char*)wg_;
        const bf16* Y = (const bf16*)(w + WS_YPRE); const bf16* GSB = (const bf16*)(w + WS_GS); bf16* CAT = (bf16*)(w + WS_CAT); float* sss = (float*)(w + WS_SSS) + (size_t)l * MT;
        const int cb = u.pn * 256 + wc * 32 + 8 * fq, rowb = u.pm * 256 + wr * 64 + fr;
        f32x4 bv[2][2];
#pragma unroll
        for (int bj = 0; bj < 2; ++bj) { bv[bj][0] = *(const f32x4*)(bias + cb + bj * 128); bv[bj][1] = *(const f32x4*)(bias + cb + bj * 128 + 4); }
#pragma unroll
        for (int ai = 0; ai < 2; ++ai)
#pragma unroll
        for (int mh = 0; mh < 2; ++mh) {
            v4u ywv[2][2], gsv[2][2];
#pragma unroll
            for (int mm = 0; mm < 2; ++mm)
#pragma unroll
                for (int bj = 0; bj < 2; ++bj) { const size_t o = (size_t)(rowb + ai * 128 + (2 * mh + mm) * 16) * DHALF + cb + bj * 128; ywv[mm][bj] = *(const v4u*)(Y + o); gsv[mm][bj] = *(const v4u*)(GSB + o); }
            asm volatile("" ::: "memory");
#pragma unroll
            for (int mm = 0; mm < 2; ++mm) { const int m = 2 * mh + mm; const int row = rowb + ai * 128 + m * 16;
                float sq = 0.f;
#pragma unroll
                for (int bj = 0; bj < 2; ++bj) { const int c = cb + bj * 128;
                    const v4u yw = ywv[mm][bj], gw = gsv[mm][bj];
                    f32x4 v0 = acc[ai][bj][m][0] + bv[bj][0], v1 = acc[ai][bj][m][1] + bv[bj][1];
#pragma unroll
                    for (int e = 0; e < 4; ++e) { const unsigned w0 = yw[e >> 1], w1 = yw[2 + (e >> 1)], g0 = gw[e >> 1], g1 = gw[2 + (e >> 1)];
                        const float y0 = (e & 1) ? __builtin_bit_cast(float, w0 & 0xffff0000u) : __builtin_bit_cast(float, w0 << 16);
                        const float y1 = (e & 1) ? __builtin_bit_cast(float, w1 & 0xffff0000u) : __builtin_bit_cast(float, w1 << 16);
                        const float s0 = (e & 1) ? __builtin_bit_cast(float, g0 & 0xffff0000u) : __builtin_bit_cast(float, g0 << 16);
                        const float s1 = (e & 1) ? __builtin_bit_cast(float, g1 & 0xffff0000u) : __builtin_bit_cast(float, g1 << 16);
                        const float z0 = y0 * sigm_f(v0[e]), z1 = y1 * sigm_f(v1[e]);
                        sq += z0 * z0 + z1 * z1;
                        v0[e] = z0 * s0; v1[e] = z1 * s1; }
                    *(v4u*)(CAT + (size_t)row * DM + DHALF + c) = __builtin_bit_cast(v4u, pack8(v0, v1)); }
                sq += __shfl_xor(sq, 16); sq += __shfl_xor(sq, 32);
                if (fq == 0) unsafeAtomicAdd(sss + row, sq); }
            asm volatile("" ::: "memory");
        }
    }
};
struct EpiOut {
    static constexpr bool PERM = true, AFTER_DRAIN = false, MIDK = true;
    unsigned char* ws_; int l;
    __device__ __forceinline__ void prep(LAS unsigned char* lds, const pg8::Unit& u, int slot, int tid) const {
        if (tid < 256) {
            GAS unsigned char* wg_ = (GAS unsigned char*)ws_; asm volatile("" : "+s"(wg_)); unsigned char* const w = (unsigned char*)wg_;
            const int row = u.pm * 256 + tid;
            const float sa = ((const float*)(w + WS_SSA))[(size_t)l * MT + row], sb = ((const float*)(w + WS_SSS))[(size_t)l * MT + row];
            const float ra = 1.0f / sqrtf(sa * (1.0f / DHALF) + EPS), rs = 1.0f / sqrtf(sb * (1.0f / DHALF) + EPS);
            *(LAS f32x2*)(lds + TAB_OFF + slot * 2048 + tid * 8) = (f32x2){ra / rs, rs};
        }
    }
    __device__ __forceinline__ void midk(pg8::f32x4 (&acc)[2][2][4][2], LAS unsigned char* lds, int ui, int wr, int fr) const {
        const LAS unsigned char* tb = lds + TAB_OFF + (ui & 1) * 2048 + (wr * 64 + fr) * 8;
#pragma unroll
        for (int ai = 0; ai < 2; ++ai)
#pragma unroll
            for (int m = 0; m < 4; ++m) { const float f = *(const LAS float*)(tb + (ai * 128 + m * 16) * 8);
#pragma unroll
                for (int bj = 0; bj < 2; ++bj) { acc[ai][bj][m][0] *= f; acc[ai][bj][m][1] *= f; } }
    }
    __device__ __forceinline__ void epi(const pg8::f32x4 (&acc)[2][2][4][2], const pg8::Unit& u, int wr, int wc, int fr, int fq, LAS unsigned char* lds, int ui, bool has_next, const pg8::Unit& nxt, int tid) const {
        if (has_next) prep(lds, nxt, (ui + 1) & 1, tid);
        GAS unsigned char* wg_ = (GAS unsigned char*)ws_; asm volatile("" : "+s"(wg_)); unsigned char* const w = (unsigned char*)wg_;
        float* X = (float*)(w + WS_X); bf16* XB = (bf16*)(w + WS_XB); float* ssn = (float*)(w + WS_SS) + (size_t)(l + 1) * MT;
        const bool last = (l == NL - 1);
        const int cb = u.pn * 256 + wc * 32 + 8 * fq, rowb = u.pm * 256 + wr * 64 + fr;
        const LAS unsigned char* tb = lds + TAB_OFF + (ui & 1) * 2048 + (wr * 64 + fr) * 8 + 4;
#pragma unroll
        for (int ai = 0; ai < 2; ++ai)
#pragma unroll
        for (int mh = 0; mh < 2; ++mh) {
            v4u xv[2][2];
#pragma unroll
            for (int mm = 0; mm < 2; ++mm)
#pragma unroll
                for (int bj = 0; bj < 2; ++bj) xv[mm][bj] = *(const v4u*)(XB + (size_t)(rowb + ai * 128 + (2 * mh + mm) * 16) * DM + cb + bj * 128);
            asm volatile("" ::: "memory");
#pragma unroll
            for (int mm = 0; mm < 2; ++mm) { const int m = 2 * mh + mm; const int row = rowb + ai * 128 + m * 16;
                const float rs = *(const LAS float*)(tb + (ai * 128 + m * 16) * 8);
                float sq = 0.f;
#pragma unroll
                for (int bj = 0; bj < 2; ++bj) { const int c = cb + bj * 128; const v4u xw = xv[mm][bj];
                    f32x4 v0 = acc[ai][bj][m][0] * rs, v1 = acc[ai][bj][m][1] * rs;
#pragma unroll
                    for (int e = 0; e < 4; ++e) { const unsigned w0 = xw[e >> 1], w1 = xw[2 + (e >> 1)];
                        v0[e] += (e & 1) ? __builtin_bit_cast(float, w0 & 0xffff0000u) : __builtin_bit_cast(float, w0 << 16);
                        v1[e] += (e & 1) ? __builtin_bit_cast(float, w1 & 0xffff0000u) : __builtin_bit_cast(float, w1 << 16); }
                    if (last) { float* xo = X + (size_t)row * DM + c; *(f32x4*)xo = v0; *(f32x4*)(xo + 4) = v1; }
                    else *(v4u*)(XB + (size_t)row * DM + c) = __builtin_bit_cast(v4u, pack8(v0, v1));
                    sq += (v0[0] * v0[0] + v0[1] * v0[1]) + (v0[2] * v0[2] + v0[3] * v0[3]) + (v1[0] * v1[0] + v1[1] * v1[1]) + (v1[2] * v1[2] + v1[3] * v1[3]); }
                sq += __shfl_xor(sq, 16); sq += __shfl_xor(sq, 32);
                if (fq == 0) unsafeAtomicAdd(ssn + row, sq); }
            asm volatile("" ::: "memory");
        }
    }
};

template <bool SAMPLE>
__device__ __forceinline__ float attn_tile(LAS unsigned char* vl, const int lane, const int t0, const int hmax,
                                          const bf16* __restrict__ Qp, const unsigned char* __restrict__ Kt, const unsigned char* __restrict__ Vt,
                                          const float* __restrict__ Kc, const float* __restrict__ Vc, const float* __restrict__ Kn, const float* __restrict__ Vn,
                                          bf16* __restrict__ Op  , const bf16* __restrict__ GAp  ) {
    const int q = lane & 31, h = lane >> 5;
    const int qpos = t0 + q;
    v4u gaw[4];
#pragma unroll
    for (int i = 0; i < 4; ++i) gaw[i] = *(const v4u*)(GAp + (size_t)q * DHALF + (i >> 1) * 32 + 16 * h + (i & 1) * 8);
    bf16x8 qf[4];
#pragma unroll
    for (int ds = 0; ds < 4; ++ds) qf[ds] = *(const bf16x8*)(Qp + (size_t)q * DHALF + ds * 16 + h * 8);
    const int kslot = 16 * ((q >> 2) & 1) + (q & 3) + 4 * (q >> 3);
    const int mg = (lane >> 4) & 1, qq = (lane >> 2) & 3, pp = lane & 3;
    const int trb = (16 * h + qq) * 64 + (16 * (pp & 1) + 8 * mg + 4 * (pp >> 1)) * 2;
    f32x16 o0, o1;
#pragma unroll
    for (int r = 0; r < 16; ++r) { o0[r] = 0.f; o1[r] = 0.f; }
    float C = 1.f;
    bf16x8 kf[4]; v4u vr[4];
#define LOAD_K(hb_) do { const int hb2_ = (hb_); \
        if constexpr (!SAMPLE) { \
            const unsigned char* kb_ = Kt + (size_t)(hb2_ >> 1) * 8192 + h * 1024 + (32 * (hb2_ & 1) + kslot) * 16; \
            _Pragma("unroll") for (int ds = 0; ds < 4; ++ds) kf[ds] = *(const bf16x8*)(kb_ + ds * 2048); \
        } else { \
            const int pos_ = 32 * hb2_ + kslot; \
            const float* src_ = (pos_ < PAST) ? Kc + (size_t)pos_ * DHALF : Kn + (size_t)(pos_ - PAST) * DHALF; \
            _Pragma("unroll") for (int ds = 0; ds < 4; ++ds) { const f32x4 a_ = *(const f32x4*)(src_ + ds * 16 + h * 8), b_ = *(const f32x4*)(src_ + ds * 16 + h * 8 + 4); kf[ds] = pack8(a_, b_); } \
        } } while (0)
#define LOAD_V(hb_) do { const int hb2_ = (hb_); \
        if constexpr (!SAMPLE) { \
            const unsigned char* vb_ = Vt + (size_t)(hb2_ >> 1) * 8192 + (hb2_ & 1) * 2048 + lane * 16; \
            _Pragma("unroll") for (int it = 0; it < 4; ++it) vr[it] = *(const v4u*)(vb_ + (it >> 1) * 4096 + (it & 1) * 1024); \
        } else { \
            _Pragma("unroll") for (int it = 0; it < 4; ++it) { const int pos_ = 32 * hb2_ + it * 8 + (lane >> 3); \
                const float* src_ = ((pos_ < PAST) ? Vc + (size_t)pos_ * DHALF : Vn + (size_t)(pos_ - PAST) * DHALF) + (lane & 7) * 8; \
                const f32x4 a_ = *(const f32x4*)src_, b_ = *(const f32x4*)(src_ + 4); vr[it] = __builtin_bit_cast(v4u, pack8(a_, b_)); } \
        } } while (0)
    LOAD_K(hmax); LOAD_V(hmax);
    for (int hb = hmax;; --hb) {
        f32x16 p;
#pragma unroll
        for (int r = 0; r < 16; ++r) p[r] = 0.f;
#pragma unroll
        for (int ds = 0; ds < 4; ++ds) p = MFMA32(kf[ds], qf[ds], p);
        if constexpr (!SAMPLE) {
#pragma unroll
            for (int it = 0; it < 4; ++it) *(LAS v4u*)(vl + (it >> 1) * 2048 + (it & 1) * 1024 + lane * 16) = vr[it];
        } else {
#pragma unroll
            for (int it = 0; it < 4; ++it) { const int key = it * 8 + (lane >> 3), ch = lane & 7; *(LAS v4u*)(vl + (ch >> 2) * 2048 + key * 64 + (ch & 3) * 16) = vr[it]; }
        }
        if constexpr (!SAMPLE) { if (hb > 0) { LOAD_K(hb - 1); LOAD_V(hb - 1); } }
        const int kb0 = 32 * hb + 16 * h;
        if (32 * hb + 31 >= t0) {
#pragma unroll
            for (int r = 0; r < 16; ++r) if (kb0 + r >= qpos) p[r] = -INFINITY;
        }
#pragma unroll
        for (int r = 0; r < 16; ++r) p[r] = rcp(1.f + ex2(p[r]));
        float T = p[0] * p[1];
#pragma unroll
        for (int r = 2; r < 16; ++r) T *= p[r];
        const float Tp = __shfl_xor(T, 32);
        float E = h ? C : C * Tp;
        C = C * (T * Tp);
#pragma unroll
        for (int r = 15; r >= 0; --r) { const float rr = p[r]; p[r] = __builtin_fmaf(-rr, E, E); E *= rr; }
        bf16x8 w[2];
        { v4u t;
          t.x = cvtpk(p[0], p[1]); t.y = cvtpk(p[2], p[3]); t.z = cvtpk(p[4], p[5]); t.w = cvtpk(p[6], p[7]); w[0] = __builtin_bit_cast(bf16x8, t);
          t.x = cvtpk(p[8], p[9]); t.y = cvtpk(p[10], p[11]); t.z = cvtpk(p[12], p[13]); t.w = cvtpk(p[14], p[15]); w[1] = __builtin_bit_cast(bf16x8, t); }
        asm volatile("" ::: "memory");
#pragma unroll
        for (int s = 0; s < 2; ++s) {
            const LAS unsigned char* vp = vl + trb + s * 512;
            const s16x4 a0l = vtr(vp), a0h = vtr(vp + 256), a1l = vtr(vp + 2048), a1h = vtr(vp + 2048 + 256);
            const bf16x8 A0 = {a0l[0], a0l[1], a0l[2], a0l[3], a0h[0], a0h[1], a0h[2], a0h[3]};
            const bf16x8 A1 = {a1l[0], a1l[1], a1l[2], a1l[3], a1h[0], a1h[1], a1h[2], a1h[3]};
            o0 = MFMA32(A0, w[s], o0); o1 = MFMA32(A1, w[s], o1);
        }
        asm volatile("" ::: "memory");
        if (hb == 0) break;
        if (__all(C < EXIT_THR)) break;
        if constexpr (SAMPLE) { LOAD_K(hb - 1); LOAD_V(hb - 1); }
    }
    float ssq = 0.f;
#pragma unroll
    for (int r = 0; r < 16; ++r) ssq += o0[r] * o0[r] + o1[r] * o1[r];
    bf16* op = Op + (size_t)q * DM + 16 * h;
#pragma unroll
    for (int dt = 0; dt < 2; ++dt) {
        f32x4 v[4];
#pragma unroll
        for (int i = 0; i < 4; ++i)
#pragma unroll
            for (int e = 0; e < 4; ++e) { const int r = 4 * i + e; const unsigned gw = gaw[dt * 2 + (r >> 3)][(r & 7) >> 1];
                const float gav = (r & 1) ? __builtin_bit_cast(float, gw & 0xffff0000u) : __builtin_bit_cast(float, gw << 16);
                v[i][e] = (dt ? o1[r] : o0[r]) * gav; }
        *(v4u*)(op + dt * 32) = __builtin_bit_cast(v4u, pack8(v[0], v[1])); *(v4u*)(op + dt * 32 + 8) = __builtin_bit_cast(v4u, pack8(v[2], v[3]));
    }
    return ssq;
}
#undef LOAD_K
#undef LOAD_V

template <bool PASS2>
__device__ __forceinline__ void ssm_pass(LAS unsigned char* vl, const int lane, const int g, const bf16* __restrict__ U, bf16* __restrict__ Y,
                                         const int sbase0, const int sbase1, const int nsteps,
                                         const bf16x8 (&bre)[2], const bf16x8 (&bim)[2], const float (&ar)[2], const float (&ai)[2],
                                         const bf16x8 (&cf)[4], const bf16x8 df, float (&sr)[2], float (&si)[2]) {
    const int m = lane & 31, kh = lane >> 5;
    const int sm = (m >> 2) & 1, tok = (m & 3) + 4 * (m >> 3);
    const bf16* up = U + ((size_t)g * MT + (sm ? sbase1 : sbase0) + tok) * NC + kh * 8;
    const int tk = lane & 15, kg = lane >> 4, qq = (lane >> 2) & 3, pp = lane & 3;
    const bf16* ud0 = U + ((size_t)g * MT + sbase0 + tk) * NC + (kg & 1) * 8;
    const bf16* ud1 = U + ((size_t)g * MT + sbase1 + tk) * NC + (kg & 1) * 8;
    bf16x8 uf_n = *(const bf16x8*)up;
    v4u uw_n[2] = {(v4u){0u, 0u, 0u, 0u}, (v4u){0u, 0u, 0u, 0u}};
    if constexpr (PASS2) { uw_n[0] = *(const v4u*)ud0; uw_n[1] = *(const v4u*)ud1; }
    for (int step = 0; step < nsteps; ++step) {
        const bf16x8 uf = *(const bf16x8*)(up + (size_t)step * 16 * NC); v4u uw0 = uw_n[0], uw1 = uw_n[1];
        if constexpr (PASS2) { uw0 = *(const v4u*)(ud0 + (size_t)step * 16 * NC); uw1 = *(const v4u*)(ud1 + (size_t)step * 16 * NC); }
        f32x16 z;
#pragma unroll
        for (int r = 0; r < 16; ++r) z[r] = 0.f;
        f32x16 br[2], bi[2];
#pragma unroll
        for (int pt = 0; pt < 2; ++pt) { br[pt] = MFMA32(uf, bre[pt], z); bi[pt] = MFMA32(uf, bim[pt], z); }
#pragma unroll
        for (int pt = 0; pt < 2; ++pt)
#pragma unroll
            for (int r = 0; r < 16; ++r) {
                const float nr = __builtin_fmaf(ar[pt], sr[pt], __builtin_fmaf(-ai[pt], si[pt], br[pt][r]));
                const float ni = __builtin_fmaf(ar[pt], si[pt], __builtin_fmaf(ai[pt], sr[pt], bi[pt][r]));
                sr[pt] = nr; si[pt] = ni;
                if constexpr (PASS2) { br[pt][r] = nr; bi[pt][r] = ni; }
            }
        if constexpr (PASS2) {
#pragma unroll
            for (int pt = 0; pt < 2; ++pt) {
                LAS unsigned char* wre = vl + kh * 4096 + (m + 32 * pt) * 32;
                LAS unsigned char* wim = wre + 64 * 32;
                { f32x4 a = {br[pt][0], br[pt][1], br[pt][2], br[pt][3]}, b = {br[pt][4], br[pt][5], br[pt][6], br[pt][7]}, c = {br[pt][8], br[pt][9], br[pt][10], br[pt][11]}, d = {br[pt][12], br[pt][13], br[pt][14], br[pt][15]};
                  *(LAS v4u*)wre = __builtin_bit_cast(v4u, pack8(a, b)); *(LAS v4u*)(wre + 16) = __builtin_bit_cast(v4u, pack8(c, d)); }
                { f32x4 a = {bi[pt][0], bi[pt][1], bi[pt][2], bi[pt][3]}, b = {bi[pt][4], bi[pt][5], bi[pt][6], bi[pt][7]}, c = {bi[pt][8], bi[pt][9], bi[pt][10], bi[pt][11]}, d = {bi[pt][12], bi[pt][13], bi[pt][14], bi[pt][15]};
                  *(LAS v4u*)wim = __builtin_bit_cast(v4u, pack8(a, b)); *(LAS v4u*)(wim + 16) = __builtin_bit_cast(v4u, pack8(c, d)); }
            }
            asm volatile("" ::: "memory");
#pragma unroll
            for (int s = 0; s < 2; ++s) {
                pg8::f32x4 y = {0.f, 0.f, 0.f, 0.f};
                const LAS unsigned char* hp = vl + s * 4096 + (8 * kg + qq) * 32 + pp * 8;
#pragma unroll
                for (int ks = 0; ks < 4; ++ks) {
                    const s16x4 lo = vtr(hp + ks * 32 * 32), hi = vtr(hp + ks * 32 * 32 + 4 * 32);
                    const bf16x8 hf = {lo[0], lo[1], lo[2], lo[3], hi[0], hi[1], hi[2], hi[3]};
                    y = MFMA16(cf[ks], hf, y);
                }
                const size_t trow = (size_t)((s ? sbase1 : sbase0) + step * 16 + tk);
                v4u uw = s ? uw1 : uw0;
                if (kg >= 2) uw = (v4u){0u, 0u, 0u, 0u};
                y = MFMA16(df, __builtin_bit_cast(bf16x8, uw), y);
                uint2 o; o.x = cvtpk(gelu_tanh_f(y[0]), gelu_tanh_f(y[1])); o.y = cvtpk(gelu_tanh_f(y[2]), gelu_tanh_f(y[3]));
                *(uint2*)(Y + trow * DHALF + g * NC + 4 * kg) = o;
            }
            asm volatile("" ::: "memory");
        }
    }
}
struct SsmPar { bf16x8 bre[2], bim[2]; float ar[2], ai[2]; };
__device__ __forceinline__ void ssm_load_par(SsmPar& P, const float* ABAR, const bf16* BBF, int l, int g, int lane) {
    const int p = lane & 31, kh = lane >> 5;
#pragma unroll
    for (int pt = 0; pt < 2; ++pt) {
        const f32x2 a = *(const f32x2*)(ABAR + ((size_t)(l * NG + g) * NP + p + 32 * pt) * 2); P.ar[pt] = a.x; P.ai[pt] = a.y;
        P.bre[pt] = *(const bf16x8*)(BBF + (((size_t)(l * NG + g) * 2 + 0) * NP + p + 32 * pt) * NC + kh * 8);
        P.bim[pt] = *(const bf16x8*)(BBF + (((size_t)(l * NG + g) * 2 + 1) * NP + p + 32 * pt) * NC + kh * 8);
    }
}
__device__ __forceinline__ void ssm_load_cd(bf16x8 (&cf)[4], bf16x8& df, const bf16* CBF, const float* dsk, int l, int g, int lane) {
    const int c = lane & 15, kg = lane >> 4;
#pragma unroll
    for (int ks = 0; ks < 4; ++ks) cf[ks] = *(const bf16x8*)(CBF + ((size_t)(l * NG + g) * NC + c) * (2 * NP) + 32 * ks + 8 * kg);
    const float dv = dsk[(size_t)l * DHALF + g * NC + c];
    const unsigned short db = (unsigned short)(cvtpk(dv, 0.f) & 0xffffu);
#pragma unroll
    for (int j = 0; j < 8; ++j) df[j] = (short)((kg < 2 && 8 * kg + j == c) ? db : 0);
}
struct Args { const float* in[22]; float* out; unsigned char* ws; };
enum { I_XP = 0, I_XS, I_CK, I_CV, I_SR, I_SI, I_LNG, I_WIN, I_ARE, I_AIM, I_LDT, I_BRE, I_BIM, I_CRE, I_CIM, I_D, I_WGLU, I_BGLU, I_GATT, I_GSSM, I_WOUT, I_FG };

__device__ __forceinline__ void transpose_item(const float* W, int K, int N, bf16* WT, const float* kscale, LAS float* scr, int item, int lane) {
    const int nblk = N / 32, kb = item / nblk, nb = item % nblk, k0 = 64 * kb, n0 = 32 * nb;
#pragma unroll 8
    for (int i = 0; i < 32; ++i) { const int kk = 2 * i + (lane >> 5); float v = W[(size_t)(k0 + kk) * N + n0 + (lane & 31)]; if (kscale) v *= kscale[k0 + kk]; scr[kk * 33 + (lane & 31)] = v; }
    LDS_WAIT(); asm volatile("" ::: "memory");
    const int c = lane & 7;
#pragma unroll
    for (int j = 0; j < 4; ++j) { const int n = (lane >> 3) + 8 * j; const LAS float* s = scr + (8 * c) * 33 + n;
        v4u o; o.x = cvtpk(s[0 * 33], s[1 * 33]); o.y = cvtpk(s[2 * 33], s[3 * 33]); o.z = cvtpk(s[4 * 33], s[5 * 33]); o.w = cvtpk(s[6 * 33], s[7 * 33]);
        *(v4u*)(WT + (size_t)(n0 + n) * K + k0 + 8 * c) = o; }
    LDS_WAIT(); asm volatile("" ::: "memory");
}

constexpr int TBL_OFF = LDSCTL_OFF + 1024;
constexpr int REP_P1 = 1, REP_P2 = 1, REP_P3 = 1, REP_SSM = 1, REP_ATT = 1;
__device__ __forceinline__ void stagger(int c, int n_extra, unsigned unit_ticks) {
    if (c < n_extra) return;
    const unsigned d = (unsigned)((c * 37) & 255) * unit_ticks / 256u;
    const unsigned long long t0 = rt();
    while ((unsigned long long)(rt() - t0) < d) __builtin_amdgcn_s_sleep(16);
}
__device__ __forceinline__ const float* inptr(LAS unsigned char* lds, int i) {
    const unsigned long long v = *(volatile LAS unsigned long long*)(lds + TBL_OFF + 8 * i);
    const unsigned lo = __builtin_amdgcn_readfirstlane((unsigned)v), hi = __builtin_amdgcn_readfirstlane((unsigned)(v >> 32));
    return (const float*)(GAS const float*)(((unsigned long long)hi << 32) | lo);
}
__global__ void __launch_bounds__(NWAVES * 64, 2) hymba_fwd(Args args) {
    extern __shared__ __attribute__((aligned(16))) unsigned char lds_raw[];
    LAS unsigned char* lds = (LAS unsigned char*)lds_raw;
    volatile LAS unsigned* MISC = (volatile LAS unsigned*)(lds + MISC_OFF);
    const int tid = threadIdx.x, lane0 = tid & 63, wave = __builtin_amdgcn_readfirstlane(tid >> 6);
    const int G = gridDim.x, bid = blockIdx.x;
    unsigned char* const ws = args.ws;
    float* const out = args.out;
    for (int u = tid; u < (LDS_BYTES - LDSCTL_OFF) / 4; u += NWAVES * 64) ((LAS unsigned*)(lds + LDSCTL_OFF))[u] = 0u;
    __syncthreads();
    if (tid < 22) *(LAS unsigned long long*)(lds + TBL_OFF + 8 * tid) = (unsigned long long)args.in[tid];
    __syncthreads();
    XcdBarrier bar = xcd_barrier_post((unsigned*)(ws + WS_CTL) + CW_BAR, MISC + 8);
    const int gw = bid * NWAVES + wave, NGW = G * NWAVES;
    LAS unsigned char* wl = lds + wave * 8192;
#define INP(i) inptr(lds, (i))
#define GRID_BAR() do { XcdBarrier b2_ = bar; asm volatile("" : "+s"(b2_.x)); xcd_barrier(b2_); } while (0)
#define LNL int lane = lane0; asm volatile("" : "+v"(lane))
#define WSL(name) GAS unsigned char* name##_g = (GAS unsigned char*)ws; asm volatile("" : "+s"(name##_g)); unsigned char* const name = (unsigned char*)name##_g

#ifndef SKIP_P0
    {
        LAS float* scr = (LAS float*)(lds + wave * 16384);
        WSL(w); LNL;
        float* SS = (float*)(w + WS_SS); float* ABAR = (float*)(w + WS_ABAR); bf16* BBF = (bf16*)(w + WS_BBF); bf16* CBF = (bf16*)(w + WS_CBF);
        bf16* WIN = (bf16*)(w + WS_WIN); bf16* WOUT = (bf16*)(w + WS_WOUT); bf16* WGLU = (bf16*)(w + WS_WGLU); bf16* XB = (bf16*)(w + WS_XB);
        constexpr int I_IN = (DM / 64) * (DIN / 32), I_OUT = (DM / 64) * (DM / 32), I_GLU = (DHALF / 64) * (DHALF / 32);
        constexpr int PER_L = I_IN + I_OUT + I_GLU, NITEMS = NL * PER_L;
        for (int it = gw; it < NITEMS; it += NGW) {
            const int l = it / PER_L; int r = it % PER_L;
            if (r < I_IN) { transpose_item(INP(I_WIN) + (size_t)l * DM * DIN, DM, DIN, WIN + (size_t)l * DIN * DM, INP(I_LNG) + (size_t)l * DM, scr, r, lane); continue; } r -= I_IN;
            if (r < I_OUT) { transpose_item(INP(I_WOUT) + (size_t)l * DM * DM, DM, DM, WOUT + (size_t)l * DM * DM, ((r / (DM / 32)) * 64 < DHALF ? INP(I_GATT) + (size_t)l * DHALF : INP(I_GSSM) + (size_t)l * DHALF - DHALF), scr, r, lane); continue; } r -= I_OUT;
            transpose_item(INP(I_WGLU) + (size_t)l * DHALF * DHALF, DHALF, DHALF, WGLU + (size_t)l * DHALF * DHALF, nullptr, scr, r, lane);
        }
        for (int i = bid * (NWAVES * 64) + tid; i < NL * NG * NP; i += G * NWAVES * 64) {
            const int p = i % NP, lg = i / NP;
            const float dt = expf(INP(I_LDT)[lg]);
            const float are = INP(I_ARE)[i], aim = INP(I_AIM)[i];
            const float mag = expf(are * dt), ang = aim * dt;
            const float abr = mag * cosf(ang), abi = mag * sinf(ang);
            const float den = are * are + aim * aim;
            const float fre = ((abr - 1.0f) * are + abi * aim) / den, fim = (abi * are - (abr - 1.0f) * aim) / den;
            ABAR[(size_t)i * 2] = abr; ABAR[(size_t)i * 2 + 1] = abi;
            const float* bre = INP(I_BRE) + (size_t)i * NC; const float* bim = INP(I_BIM) + (size_t)i * NC;
#pragma unroll
            for (int c = 0; c < NC; c += 2) {
                const float r0 = fre * bre[c] - fim * bim[c], i0 = fre * bim[c] + fim * bre[c];
                const float r1 = fre * bre[c + 1] - fim * bim[c + 1], i1 = fre * bim[c + 1] + fim * bre[c + 1];
                *(unsigned*)(BBF + (((size_t)lg * 2 + 0) * NP + p) * NC + c) = cvtpk(r0, r1);
                *(unsigned*)(BBF + (((size_t)lg * 2 + 1) * NP + p) * NC + c) = cvtpk(i0, i1);
            }
            const float* cre = INP(I_CRE); const float* cim = INP(I_CIM);
#pragma unroll
            for (int c = 0; c < NC; ++c) {
                const float cr = cre[((size_t)lg * NC + c) * NP + p], ci = cim[((size_t)lg * NC + c) * NP + p];
                CBF[((size_t)lg * NC + c) * (2 * NP) + p] = (bf16)(cvtpk(cr, 0.f) & 0xffffu);
                CBF[((size_t)lg * NC + c) * (2 * NP) + NP + p] = (bf16)(cvtpk(-ci, 0.f) & 0xffffu);
            }
        }
        const float* xp = INP(I_XP); const float* xs = INP(I_XS);
        for (int row = gw; row < MT; row += NGW) {
            const float* xr = (row < MP) ? xp + (size_t)row * DM : xs + (size_t)(row - MP) * DM;
            float s = 0.f;
#pragma unroll
            for (int j = 0; j < 2; ++j) { const f32x4 a = *(const f32x4*)(xr + j * 512 + lane * 8), b = *(const f32x4*)(xr + j * 512 + lane * 8 + 4);
                s += (a[0] * a[0] + a[1] * a[1]) + (a[2] * a[2] + a[3] * a[3]) + (b[0] * b[0] + b[1] * b[1]) + (b[2] * b[2] + b[3] * b[3]);
                *(v4u*)(XB + (size_t)row * DM + j * 512 + lane * 8) = __builtin_bit_cast(v4u, pack8(a, b)); }
            s = wave_sum(s);
            if (lane == 0) SS[row] = s;
        }
    }
#endif
    GRID_BAR();

    for (int l = 0; l < NL; ++l) {
#ifndef SKIP_P1
        for (int rep = 0; rep < REP_P1; ++rep)
        {
            WSL(w);
            pg8::Gemm g{(const bf16*)(w + WS_XB), (const bf16*)(w + WS_WIN) + (size_t)l * DIN * DM, MT, DIN, DM}; pg8::StaticOrder S; S.init(MT, DIN, G, bid);
            EpiProj E{ws, out, l};
            pg8::gemm_phase<EpiProj, pg8::StaticOrder, true, true>(lds, g, S, E);
        }
#endif
        GRID_BAR();
#ifndef SKIP_P2
        for (int rep = 0; rep < REP_P2; ++rep)
        {
#ifndef SKIP_SSM
            for (int rs = 0; rs < REP_SSM; ++rs)
            for (int ui = bid; ui < NB * NG; ui += G) {
                const int b = ui >> 5, g = ui & 31;
                WSL(w); LNL;
                const float* ABAR = (const float*)(w + WS_ABAR); const bf16* BBF = (const bf16*)(w + WS_BBF); const bf16* CBF = (const bf16*)(w + WS_CBF); const bf16* UB = (const bf16*)(w + WS_U); bf16* YPRE = (bf16*)(w + WS_YPRE);
                SsmPar P; ssm_load_par(P, ABAR, BBF, l, g, lane);
                const int h = lane >> 5, p = lane & 31;
                const int sb0 = b * TP + (2 * wave) * 256, sb1 = sb0 + 256;
                float sr[2] = {0.f, 0.f}, si[2] = {0.f, 0.f};
                bf16x8 cf[4]; bf16x8 df;
#pragma unroll
                for (int ks = 0; ks < 4; ++ks) cf[ks] = (bf16x8){0, 0, 0, 0, 0, 0, 0, 0};
                df = (bf16x8){0, 0, 0, 0, 0, 0, 0, 0};
                ssm_pass<false>(wl, lane, g, UB, YPRE, sb0, sb1, 16, P.bre, P.bim, P.ar, P.ai, cf, df, sr, si);
                LAS f32x2* ends = (LAS f32x2*)(lds + ENDS_OFF);
#pragma unroll
                for (int pt = 0; pt < 2; ++pt) ends[(2 * wave + h) * NP + p + 32 * pt] = (f32x2){sr[pt], si[pt]};
                __syncthreads();
                const int myS = 2 * wave + h;
#pragma unroll
                for (int pt = 0; pt < 2; ++pt) {
                    float a2r = P.ar[pt], a2i = P.ai[pt];
#pragma unroll
                    for (int i = 0; i < 8; ++i) { const float t = a2r * a2r - a2i * a2i; a2i = 2.f * a2r * a2i; a2r = t; }
                    float cr = 0.f, ci = 0.f;
                    for (int s2 = 0; s2 < 15; ++s2) {
                        const f32x2 e = ends[s2 * NP + p + 32 * pt];
                        const float nr = a2r * cr - a2i * ci + e.x, ni = a2r * ci + a2i * cr + e.y;
                        if (s2 < myS) { cr = nr; ci = ni; }
                    }
                    sr[pt] = cr; si[pt] = ci;
                }
                ssm_load_cd(cf, df, CBF, INP(I_D), l, g, lane);
                ssm_pass<true>(wl, lane, g, UB, YPRE, sb0, sb1, 16, P.bre, P.bim, P.ar, P.ai, cf, df, sr, si);
                if (wave == NWAVES - 1 && h == 1) {
#pragma unroll
                    for (int pt = 0; pt < 2; ++pt) { const size_t o = ((size_t)(l * NB + b) * NG + g) * NP + p + 32 * pt; out[O_RP + o] = sr[pt]; out[O_IP + o] = si[pt]; }
                }
                __syncthreads();
            }
#endif
#ifndef SKIP_SSMS
            for (int g = G - 1 - bid; g >= 0 && g < NG; g += G) {
                WSL(w); LNL;
                const float* ABAR = (const float*)(w + WS_ABAR); const bf16* BBF = (const bf16*)(w + WS_BBF); const bf16* CBF = (const bf16*)(w + WS_CBF); const bf16* UB = (const bf16*)(w + WS_U); bf16* YPRE = (bf16*)(w + WS_YPRE);
                const float* isr = INP(I_SR); const float* isi = INP(I_SI);
                SsmPar P; ssm_load_par(P, ABAR, BBF, l, g, lane);
                const int h = lane >> 5, p = lane & 31, b = 2 * wave + h;
                float sr[2], si[2];
#pragma unroll
                for (int pt = 0; pt < 2; ++pt) { const size_t o = ((size_t)(l * NB + b) * NG + g) * NP + p + 32 * pt; sr[pt] = isr[o]; si[pt] = isi[o]; }
                bf16x8 cf[4]; bf16x8 df; ssm_load_cd(cf, df, CBF, INP(I_D), l, g, lane);
                ssm_pass<true>(wl, lane, g, UB, YPRE, MP + (2 * wave) * TSM, MP + (2 * wave + 1) * TSM, 2, P.bre, P.bim, P.ar, P.ai, cf, df, sr, si);
#pragma unroll
                for (int pt = 0; pt < 2; ++pt) { const size_t o = ((size_t)(l * NB + b) * NG + g) * NP + p + 32 * pt; out[O_RS + o] = sr[pt]; out[O_IS + o] = si[pt]; }
            }
#endif
#ifndef SKIP_ATT
            for (int ra = 0; ra < REP_ATT; ++ra)
            for (int c8 = bid; c8 < MP / 256; c8 += G) {
                WSL(w); LNL;
                const bf16* QB = (const bf16*)(w + WS_Q); const unsigned char* KT = w + WS_KT; const unsigned char* VT = w + WS_VT; bf16* CAT = (bf16*)(w + WS_CAT); const bf16* GA = (const bf16*)(w + WS_GA);
                const int unit = c8 * 8 + wave, b = unit >> 7, t0 = (unit & 127) * 32, row0 = b * TP + t0;
                float ssq = 0.f;
                for (int hd = 0; hd < NH; ++hd) {
                    const size_t hb = (size_t)(b * NH + hd) * 64 * 8192;
                    ssq += attn_tile<false>(wl, lane, t0, (t0 + 30) >> 5, QB + (size_t)row0 * DHALF + hd * HD, KT + hb, VT + hb, nullptr, nullptr, nullptr, nullptr,
                                            CAT + (size_t)row0 * DM + hd * HD, GA + (size_t)row0 * DHALF + hd * HD);
                }
                ssq += __shfl_xor(ssq, 32);
                if (lane < 32) ((float*)(w + WS_SSA))[(size_t)l * MT + row0 + lane] = ssq;
            }
#endif
#ifndef SKIP_ATTS
            for (int b = bid; b < NB; b += G) {
                WSL(w); LNL;
                const bf16* QB = (const bf16*)(w + WS_Q); bf16* CAT = (bf16*)(w + WS_CAT); const bf16* GA = (const bf16*)(w + WS_GA);
                const float* ksm = out + O_KS + (size_t)l * MS * DHALF; const float* vsm = out + O_VS + (size_t)l * MS * DHALF;
                const int row0 = MP + b * TSM;
                const size_t cb = ((size_t)(l * NB + b) * PAST) * DHALF + wave * HD;
                float ssq = attn_tile<true>(wl, lane, PAST, (PAST + 30) >> 5, QB + (size_t)row0 * DHALF + wave * HD, nullptr, nullptr, INP(I_CK) + cb, INP(I_CV) + cb,
                                ksm + (size_t)(b * TSM) * DHALF + wave * HD, vsm + (size_t)(b * TSM) * DHALF + wave * HD,
                                CAT + (size_t)row0 * DM + wave * HD, GA + (size_t)row0 * DHALF + wave * HD);
                ssq += __shfl_xor(ssq, 32);
                LAS float* red = (LAS float*)(lds + ENDS_OFF);
                if (lane < 32) red[wave * 32 + lane] = ssq;
                __syncthreads();
                if (wave == 0 && lane < 32) { float t = 0.f;
#pragma unroll
                    for (int k = 0; k < NWAVES; ++k) t += red[k * 32 + lane];
                    ((float*)(w + WS_SSA))[(size_t)l * MT + row0 + lane] = t; }
                __syncthreads();
            }
#endif
        }
#endif
        GRID_BAR();
#ifndef SKIP_P3
        for (int rep = 0; rep < REP_P3; ++rep)
        {
            WSL(w);
            pg8::Gemm g{(const bf16*)(w + WS_YPRE), (const bf16*)(w + WS_WGLU) + (size_t)l * DHALF * DHALF, MT, DHALF, DHALF}; pg8::StaticOrder S; S.init(MT, DHALF, G, bid);
            EpiGlu E{ws, INP(I_BGLU) + (size_t)l * DHALF, l};
            pg8::gemm_phase<EpiGlu, pg8::StaticOrder, true, true>(lds, g, S, E);
        }
#endif
        GRID_BAR();
#ifndef SKIP_P5
        {
            WSL(w);
            pg8::Gemm g{(const bf16*)(w + WS_CAT), (const bf16*)(w + WS_WOUT) + (size_t)l * DM * DM, MT, DM, DM}; pg8::StaticOrder S; S.init(MT, DM, G, bid);
            EpiOut E{ws, l};
            pg8::gemm_phase<EpiOut, pg8::StaticOrder, true, true>(lds, g, S, E);
        }
#endif
        GRID_BAR();
    }
    {
        WSL(w); LNL;
        const float* X = (const float*)(w + WS_X);
        const float* fg = INP(I_FG); const float* ssf = (const float*)(w + WS_SS) + (size_t)NL * MT;
        f32x4 gv[4];
#pragma unroll
        for (int j = 0; j < 4; ++j) gv[j] = *(const f32x4*)(fg + j * 256 + lane * 4);
        for (int row = gw; row < MT; row += NGW) {
            const float rs = 1.0f / sqrtf(ssf[row] * (1.0f / DM) + EPS);
            const float* xr = X + (size_t)row * DM; float* yo = (row < MP) ? out + O_YP + (size_t)row * DM : out + O_YS + (size_t)(row - MP) * DM;
#pragma unroll
            for (int j = 0; j < 4; ++j) { const f32x4 v = *(const f32x4*)(xr + j * 256 + lane * 4); *(f32x4*)(yo + j * 256 + lane * 4) = v * rs * gv[j]; }
        }
    }
}

extern "C" void kernel_launch(void* const* d_in, const int* in_sizes, int n_in, void* d_out, int out_size, void* d_ws, size_t ws_size, hipStream_t stream) {
    static int grid = 0;
    if (grid == 0) {
        if (n_in != 22 || in_sizes[0] != MP * DM || (size_t)out_size != O_END || ws_size < WS_END) {
            fprintf(stderr, "kernel_launch: unexpected shapes: n_in %d in0 %d out %d ws %zu (need %zu); nothing launched\n", n_in, n_in > 0 ? in_sizes[0] : -1, out_size, ws_size, (size_t)WS_END); grid = -1; return; }
        int dev = 0, cus = 0, per_cu = 0;
        if (hipGetDevice(&dev) != hipSuccess || hipDeviceGetAttribute(&cus, hipDeviceAttributeMultiprocessorCount, dev) != hipSuccess) { grid = -1; return; }
        if (hipFuncSetAttribute((const void*)hymba_fwd, hipFuncAttributeMaxDynamicSharedMemorySize, LDS_BYTES) != hipSuccess) { fprintf(stderr, "kernel_launch: hipFuncSetAttribute failed\n"); grid = -1; return; }
        if (hipOccupancyMaxActiveBlocksPerMultiprocessor(&per_cu, (const void*)hymba_fwd, NWAVES * 64, LDS_BYTES) != hipSuccess || per_cu < 1)
            fprintf(stderr, "kernel_launch: note: occupancy query reports %d workgroups per CU\n", per_cu);
        (void)hipGetLastError();
        grid = cus;
    }
    if (grid < 0) return;
    if (hipMemsetAsync((char*)d_ws + WS_CTL, 0, CTL_ZERO_BYTES, stream) != hipSuccess) { fprintf(stderr, "kernel_launch: memset failed\n"); return; }
    Args a{};
    for (int i = 0; i < 22; ++i) a.in[i] = (const float*)d_in[i];
    a.out = (float*)d_out; a.ws = (unsigned char*)d_ws;
    hipLaunchKernelGGL(hymba_fwd, dim3(grid), dim3(NWAVES * 64), LDS_BYTES, stream, a);
    const hipError_t le = hipPeekAtLastError();
    if (le != hipSuccess) fprintf(stderr, "kernel_launch: launch failed: %s\n", hipGetErrorName(le));
}
```
